# Optimizing an MI355X kernel written in HIP

```python
import jax, jax.numpy as jnp
from jax import lax
import numpy as np

D_MODEL = 1024
BATCH = 2
SEQ = 8192
DEPTH = 1
DEC_BATCH = 4
DEC_SEQ = 8192
PAST_LEN = 128

N_META = 16
D_A = D_MODEL
H_A = 8
BW_A = D_A // H_A
CONV_W = 4
CONV_PAD = (2, 1)
RG_C = 8.0
D_B = D_MODEL
HGRN_EXPAND = 128
H_B = D_B // HGRN_EXPAND
DK_B = D_B // H_B
DV_B = D_B // H_B
CHUNK = 64
D_FF = 4 * D_MODEL
EPS = 1e-6
N_IN = 2 * D_A + 5 * D_B + 2 * D_MODEL

kernel_name = "hybrid_rglru_hgrn2_encoder"


def rmsnorm(x, g):
    xf = x.astype(jnp.float32)
    y = xf * lax.rsqrt(jnp.mean(xf * xf, axis=-1, keepdims=True) + EPS)
    return (y * g.astype(jnp.float32)).astype(x.dtype)


def centred_depthwise_conv(x, w, b):
    y = lax.conv_general_dilated(
        x, w[:, None, :].astype(x.dtype), window_strides=(1,), padding=[CONV_PAD],
        dimension_numbers=("NWC", "WIO", "NWC"), feature_group_count=x.shape[-1])
    return y + b.astype(x.dtype)


def _linear_combine(left, right):
    a1, b1 = left
    a2, b2 = right
    return a1 * a2, a2 * b1 + b2


def rglru_direction(xc, wa, ba, wx, bx, lam, reverse):
    B, L, _ = xc.shape
    xh = xc.reshape(B, L, H_A, BW_A)
    r = jax.nn.sigmoid(jnp.einsum("blhi,hij->blhj", xh, wa.astype(jnp.float32)).reshape(B, L, D_A)
                       + ba.astype(jnp.float32))
    i = jax.nn.sigmoid(jnp.einsum("blhi,hij->blhj", xh, wx.astype(jnp.float32)).reshape(B, L, D_A)
                       + bx.astype(jnp.float32))
    log_a = -RG_C * jax.nn.softplus(-lam.astype(jnp.float32)) * r
    a = jnp.exp(log_a)
    mult = jnp.sqrt(-jnp.expm1(2.0 * log_a))
    u = mult * (i * xc)
    _, h = lax.associative_scan(_linear_combine, (a, u), axis=1, reverse=reverse)
    return h


def gla_chunk_scan(q, k, v, logf, s0, chunk):
    B, T, H, K = q.shape
    V = v.shape[-1]
    n = T // chunk

    def to_chunks(t):
        return jnp.moveaxis(t.reshape(B, n, chunk, H, t.shape[-1]), 1, 0)

    qc, kc, vc, gc = (to_chunks(t) for t in (q, k, v, logf))
    bc = jnp.cumsum(gc, axis=2)
    causal = jnp.tril(jnp.ones((chunk, chunk), dtype=bool))[None, :, :, None, None]

    def step(S, inp):
        qi, ki, vi, bi = inp
        o_inter = jnp.einsum("bthk,bhkv->bthv", qi * jnp.exp(bi), S)
        diff = bi[:, :, None] - bi[:, None, :]
        decay = jnp.exp(jnp.where(causal, diff, -jnp.inf))
        scores = jnp.einsum("bthk,bshk,btshk->bhts", qi, ki, decay)
        o_intra = jnp.einsum("bhts,bshv->bthv", scores, vi)
        b_last = bi[:, -1]
        S_new = jnp.exp(b_last)[..., None] * S + jnp.einsum(
            "bshk,bshv->bhkv", ki * jnp.exp(b_last[:, None] - bi), vi)
        return S_new, o_inter + o_intra

    S_T, o = lax.scan(step, s0, (qc, kc, vc, bc))
    o = jnp.moveaxis(o, 0, 1).reshape(B, T, H, V)
    return o, S_T


def hgrn2_bidirectional(q, k_f, k_b, v, g_f, g_b):
    B = q.shape[0]
    m = N_META
    zero = jnp.zeros((B, H_B, DK_B, DV_B), jnp.float32)
    flip = lambda t: jnp.flip(t, axis=1)
    o_meta_f, s_meta = gla_chunk_scan(q[:, :m], k_f[:, :m], v[:, :m], g_f[:, :m], zero, m)
    o_real_f, _ = gla_chunk_scan(q[:, m:], k_f[:, m:], v[:, m:], g_f[:, m:], s_meta, CHUNK)
    o_real_b, s_real = gla_chunk_scan(flip(q[:, m:]), flip(k_b[:, m:]), flip(v[:, m:]),
                                      flip(g_b[:, m:]), zero, CHUNK)
    o_meta_b, _ = gla_chunk_scan(flip(q[:, :m]), flip(k_b[:, :m]), flip(v[:, :m]),
                                 flip(g_b[:, :m]), s_real, m)
    o_f = jnp.concatenate([o_meta_f, o_real_f], axis=1)
    o_b = jnp.concatenate([flip(o_meta_b), flip(o_real_b)], axis=1)
    return o_f + o_b


def hybrid_layer(x, lb, norm_mix_g, w_in, conv_w, conv_b, rg_wa, rg_ba, rg_wx, rg_bx, rg_lambda,
                 hg_norm_g, w_branch_a, w_branch_b, w_out, norm_mlp_g, w_mlp1, w_mlp2):
    B, L, _ = x.shape
    f32 = jnp.float32
    h = rmsnorm(x, norm_mix_g)
    z = h @ w_in.astype(h.dtype)
    sizes = [D_A, D_A, D_B, D_B, D_B, D_B, D_B, D_MODEL, D_MODEL]
    idx = np.cumsum(sizes)[:-1].tolist()
    xa, ya, q_raw, ff_raw, fb_raw, v_raw, og_raw, gate_a, gate_b = jnp.split(z, idx, axis=-1)

    xc = centred_depthwise_conv(xa, conv_w, conv_b).astype(f32)
    h_rnn = (rglru_direction(xc, rg_wa[0], rg_ba[0], rg_wx[0], rg_bx[0], rg_lambda[0], False)
             + rglru_direction(xc, rg_wa[1], rg_ba[1], rg_wx[1], rg_bx[1], rg_lambda[1], True))
    branch_a = (h_rnn * jax.nn.gelu(ya.astype(f32))).astype(x.dtype)

    heads = lambda t: t.astype(f32).reshape(B, L, H_B, -1)
    qh = heads(jax.nn.silu(q_raw.astype(f32)))
    vh = heads(v_raw)

    def forget(f_raw, lbd):
        f = lbd + (1.0 - lbd) * jax.nn.sigmoid(f_raw.astype(f32))
        return heads(1.0 - f), heads(jnp.log(f))

    k_f, g_f = forget(ff_raw, lb[0])
    k_b, g_b = forget(fb_raw, lb[1])
    o = hgrn2_bidirectional(qh, k_f, k_b, vh, g_f, g_b)
    o = o * lax.rsqrt(jnp.mean(o * o, axis=-1, keepdims=True) + EPS)
    o = o.reshape(B, L, D_B) * hg_norm_g.astype(f32) * jax.nn.silu(og_raw.astype(f32))
    branch_b = o.astype(x.dtype)

    merged = (jax.nn.sigmoid(gate_a) * (branch_a @ w_branch_a.astype(x.dtype))
              + jax.nn.sigmoid(gate_b) * (branch_b @ w_branch_b.astype(x.dtype)))
    x = x + merged @ w_out.astype(x.dtype)

    hm = rmsnorm(x, norm_mlp_g) @ w_mlp1.astype(x.dtype)
    x = x + jnp.square(jax.nn.relu(hm)) @ w_mlp2.astype(x.dtype)
    return x


def encode(x, meta_tokens, hg_lb_logits, norm_mix_g, w_in, conv_w, conv_b, rg_wa, rg_ba, rg_wx, rg_bx,
           rg_lambda, hg_norm_g, w_branch_a, w_branch_b, w_out, norm_mlp_g, w_mlp1, w_mlp2, final_norm_g):
    B = x.shape[0]
    meta = jnp.broadcast_to(meta_tokens.astype(x.dtype)[None], (B, N_META, D_MODEL))
    h = jnp.concatenate([meta, x], axis=1)
    lb_all = jnp.cumsum(jax.nn.softmax(hg_lb_logits.astype(jnp.float32), axis=0), axis=0)
    for l in range(DEPTH):
        h = hybrid_layer(h, lb_all[l], norm_mix_g[l], w_in[l], conv_w[l], conv_b[l], rg_wa[l], rg_ba[l],
                         rg_wx[l], rg_bx[l], rg_lambda[l], hg_norm_g[l], w_branch_a[l], w_branch_b[l],
                         w_out[l], norm_mlp_g[l], w_mlp1[l], w_mlp2[l])
    return rmsnorm(h[:, N_META:], final_norm_g)


def setup_inputs(seed: int = 0) -> dict:
    key = jax.random.key(seed)
    ks = jax.random.split(key, 24)
    nrm = lambda k, shape, s: jax.random.normal(k, shape, jnp.float32) * s
    u = jax.random.uniform(ks[12], (DEPTH, 2, D_A), jnp.float32, minval=0.9, maxval=0.999)
    root = u ** (1.0 / RG_C)
    rg_lambda = jnp.log(root) - jnp.log1p(-root)
    return {
        "x_prompt": nrm(ks[0], (BATCH, SEQ, D_MODEL), 1.0),
        "x_sample": nrm(ks[1], (DEC_BATCH, DEC_SEQ, D_MODEL), 1.0),
        "meta_tokens": nrm(ks[2], (N_META, D_MODEL), 1.0),
        "hg_lb_logits": nrm(ks[3], (DEPTH + 1, 2, D_B), 0.5),
        "norm_mix_g": 1.0 + nrm(ks[4], (DEPTH, D_MODEL), 0.02),
        "w_in": nrm(ks[5], (DEPTH, D_MODEL, N_IN), D_MODEL ** -0.5),
        "conv_w": nrm(ks[6], (DEPTH, CONV_W, D_A), CONV_W ** -0.5),
        "conv_b": nrm(ks[7], (DEPTH, D_A), 0.01),
        "rg_wa": nrm(ks[8], (DEPTH, 2, H_A, BW_A, BW_A), BW_A ** -0.5),
        "rg_ba": nrm(ks[9], (DEPTH, 2, D_A), 0.01),
        "rg_wx": nrm(ks[10], (DEPTH, 2, H_A, BW_A, BW_A), BW_A ** -0.5),
        "rg_bx": nrm(ks[11], (DEPTH, 2, D_A), 0.01),
        "rg_lambda": rg_lambda,
        "hg_norm_g": 1.0 + nrm(ks[13], (DEPTH, D_B), 0.02),
        "w_branch_a": nrm(ks[14], (DEPTH, D_A, D_MODEL), D_A ** -0.5),
        "w_branch_b": nrm(ks[15], (DEPTH, D_B, D_MODEL), D_B ** -0.5),
        "w_out": nrm(ks[16], (DEPTH, D_MODEL, D_MODEL), D_MODEL ** -0.5),
        "norm_mlp_g": 1.0 + nrm(ks[17], (DEPTH, D_MODEL), 0.02),
        "w_mlp1": nrm(ks[18], (DEPTH, D_MODEL, D_FF), D_MODEL ** -0.5),
        "w_mlp2": nrm(ks[19], (DEPTH, D_FF, D_MODEL), D_FF ** -0.5),
        "final_norm_g": 1.0 + nrm(ks[20], (D_MODEL,), 0.02),
    }


def reference(x_prompt, x_sample, meta_tokens, hg_lb_logits, norm_mix_g, w_in, conv_w, conv_b, rg_wa, rg_ba,
              rg_wx, rg_bx, rg_lambda, hg_norm_g, w_branch_a, w_branch_b, w_out, norm_mlp_g, w_mlp1, w_mlp2,
              final_norm_g):
    y_prompt = encode(x_prompt, meta_tokens, hg_lb_logits, norm_mix_g, w_in, conv_w, conv_b, rg_wa, rg_ba,
                      rg_wx, rg_bx, rg_lambda, hg_norm_g, w_branch_a, w_branch_b, w_out, norm_mlp_g, w_mlp1,
                      w_mlp2, final_norm_g)
    y_sample = encode(x_sample, meta_tokens, hg_lb_logits, norm_mix_g, w_in, conv_w, conv_b, rg_wa, rg_ba,
                      rg_wx, rg_bx, rg_lambda, hg_norm_g, w_branch_a, w_branch_b, w_out, norm_mlp_g, w_mlp1,
                      w_mlp2, final_norm_g)
    return (y_prompt, y_sample)
```

```cpp
#include <hip/hip_runtime.h>
#include <cstdio>
#include <cstdint>
namespace pg8 {
#define PG8_LAS __attribute__((address_space(3)))
typedef unsigned short bf16_t;
typedef short bf16x8 __attribute__((ext_vector_type(8)));
typedef float f32x4 __attribute__((ext_vector_type(4)));
typedef unsigned u32x4 __attribute__((ext_vector_type(4)));
constexpr int BM = 256, BK = 64, HALF = 128, HTB = HALF * BK * 2  , STAGE_BYTES = 8 * HTB, NXCD = 8, WGM = 8;

__host__ __device__ __forceinline__ int lds_byte(int r, int c) { const int st = (r >> 4) * 2 + (c >> 5), rr = r & 15, cc = c & 31, ob = rr * 64 + cc * 2; return st * 1024 + (ob ^ (((ob >> 9) & 1) << 5)); }
__host__ __device__ __forceinline__ void stage_rc(int b, int& R, int& C) { const int st = b / 1024, sb = b % 1024, swz = sb ^ (((sb >> 9) & 1) << 5); R = (st >> 1) * 16 + swz / 64; C = (st & 1) * 32 + (swz % 64) / 2; }
__host__ __device__ __forceinline__ int perm32(int rho) { const int n = rho >> 4, i = rho & 15; return 8 * (i >> 2) + 4 * n + (i & 3); }

struct Unit { int pm, pn; };
struct Gemm { const bf16_t* A; const bf16_t* Bt; int M, N, K; const bf16_t* A2; int pm_split; };

struct StaticOrder {
    int nM, nN, nwg, G, c;
    __host__ __device__ void init(int M, int N, int G_, int c_) { nM = M / BM; nN = N / BM; nwg = nM * nN; G = G_; c = c_; }
    __host__ __device__ bool next(int i, Unit& u) const {
        const long L = (long)i * G + c; if (L >= nwg) return false;
        int wgid = (int)L; { const int q = nwg / NXCD, r = nwg % NXCD, xcd = wgid % NXCD, off = wgid / NXCD; wgid = (xcd < r ? xcd * (q + 1) : r * (q + 1) + (xcd - r) * q) + off; }
        const int nig = WGM * nN, gid = wgid / nig, fm = gid * WGM, gsz = (nM - fm) < WGM ? (nM - fm) : WGM;
        u.pm = fm + ((wgid % nig) % gsz); u.pn = (wgid % nig) / gsz; return true;
    }
    __device__ __forceinline__ void a_ready(const Unit&) const {}
    __device__ __forceinline__ void done(const Unit&) const {}
};

__device__ __forceinline__ unsigned cvt_pk_bf16(float lo, float hi) { unsigned r; asm volatile("v_cvt_pk_bf16_f32 %0, %1, %2" : "=v"(r) : "v"(lo), "v"(hi)); return r; }
typedef float f32x2 __attribute__((ext_vector_type(2)));
template <class F> struct EpiRow8 {
    static constexpr bool PERM = true, AFTER_DRAIN = false; F f;
    __device__ __forceinline__ void operator()(const f32x4 (&acc)[2][2][4][2], const Unit& u, int wr, int wc, int fr, int fq) const {
        const int row0 = u.pm * BM + wr * 64 + fr, col0 = u.pn * BM + wc * 32 + 8 * fq;
#pragma unroll
        for (int ai = 0; ai < 2; ++ai)
#pragma unroll
            for (int m = 0; m < 4; ++m) {
#pragma unroll
                for (int bj = 0; bj < 2; ++bj) f(row0 + ai * HALF + m * 16, col0 + bj * HALF, acc[ai][bj][m][0], acc[ai][bj][m][1]);
                if (m & 1) asm volatile("" ::: "memory"); }
    }
};
#define PG8_ABASE(pm) ((pm) < g.pm_split ? (const char*)g.A + (size_t)(pm) * tstep : (const char*)g.A2 + (size_t)((pm) - g.pm_split) * tstep)
template <class Epi, class Sched, bool ALIGN_EPI = false, bool SP2 = false>
__device__ __forceinline__ void gemm_phase(PG8_LAS unsigned char* lds, const Gemm g, const Sched& S, const Epi& E) {
    const int tid = threadIdx.x, wid = __builtin_amdgcn_readfirstlane(tid >> 6), lane = tid & 63, wr = wid >> 2, wc = wid & 3, fr = lane & 15, fq = lane >> 4;
    const int K = g.K, nt = K / BK;
    unsigned voffA[2], voffB[2];
#pragma unroll
    for (int i = 0; i < 2; ++i) { int R, C; stage_rc(tid * 16 + i * 8192, R, C); const int Rb = Epi::PERM ? ((R & ~31) + perm32(R & 31)) : R;
        voffA[i] = (unsigned)(R * K + C) * 2u; voffB[i] = (unsigned)(Rb * K + C) * 2u; }
    const size_t kstep = (size_t)(BK * 2);
    const size_t hstep = (size_t)HALF * K * 2;
    const size_t tstep = 2 * hstep;
    const unsigned ldsw = (unsigned)wid * 1024u;
    const int aoff = lds_byte(wr * 64 + fr, fq * 8), boff = lds_byte(wc * 32 + fr, fq * 8);
#define PG8_SA(b, h) (((b) * 2 + (h)) * HTB)
#define PG8_SB(b, h) ((4 + (b) * 2 + (h)) * HTB)
#define PG8_STAGE(bufoff, gbase, voff) do { _Pragma("unroll") for (int _i = 0; _i < 2; ++_i) \
        __builtin_amdgcn_global_load_lds((const unsigned*)((const char*)(gbase) + (voff)[_i]), (PG8_LAS unsigned*)(lds + (bufoff) + ldsw + _i * 8192), 16, 0, 0); } while (0)
#define PG8_LDA(dst, b, h) do { _Pragma("unroll") for (int m = 0; m < 4; ++m) _Pragma("unroll") for (int k = 0; k < 2; ++k) dst[m][k] = *(const PG8_LAS bf16x8*)(lds + PG8_SA(b, h) + aoff + m * 2048 + k * 1024); } while (0)
#define PG8_LDB(dst, b, h) do { _Pragma("unroll") for (int n = 0; n < 2; ++n) _Pragma("unroll") for (int k = 0; k < 2; ++k) dst[n][k] = *(const PG8_LAS bf16x8*)(lds + PG8_SB(b, h) + boff + n * 2048 + k * 1024); } while (0)
#define PG8_MMA(ai, bj, At, Bt) do { __builtin_amdgcn_s_setprio(1); _Pragma("unroll") for (int m = 0; m < 4; ++m) _Pragma("unroll") for (int n = 0; n < 2; ++n) _Pragma("unroll") for (int k = 0; k < 2; ++k) \
        acc[ai][bj][m][n] = __builtin_amdgcn_mfma_f32_16x16x32_bf16(Bt[n][k], At[m][k], acc[ai][bj][m][n], 0, 0, 0); __builtin_amdgcn_s_setprio(0); } while (0)
#define PG8_WAIT_V(n) asm volatile("s_waitcnt vmcnt(" #n ")" ::: "memory")
#define PG8_WAIT_L(n) asm volatile("s_waitcnt lgkmcnt(" #n ")" ::: "memory")
#define PG8_BAR __builtin_amdgcn_s_barrier()
#define PG8_SCHED __builtin_amdgcn_sched_barrier(0)
    Unit cur, nxt; int ui = 0;
    if (!S.next(0, cur)) return;
    f32x4 acc[2][2][4][2];
#pragma unroll
    for (int a = 0; a < 2; ++a)
#pragma unroll
        for (int b = 0; b < 2; ++b)
#pragma unroll
            for (int m = 0; m < 4; ++m)
#pragma unroll
                for (int n = 0; n < 2; ++n) acc[a][b][m][n] = (f32x4){0.f, 0.f, 0.f, 0.f};
    bf16x8 At[4][2], B0[2][2], B1[2][2];
    const char* cA = PG8_ABASE(cur.pm); const char* cB = (const char*)g.Bt + (size_t)cur.pn * tstep;
    S.a_ready(cur);
    if constexpr (SP2) {
        PG8_STAGE(PG8_SB(0, 0), cB, voffB); PG8_STAGE(PG8_SB(0, 1), cB + hstep, voffB); PG8_STAGE(PG8_SA(0, 0), cA, voffA); PG8_STAGE(PG8_SA(0, 1), cA + hstep, voffA);
        if (wr == 1) PG8_BAR;
        PG8_WAIT_V(2); PG8_BAR;
        PG8_STAGE(PG8_SB(1, 0), cB + kstep, voffB); PG8_STAGE(PG8_SA(1, 0), cA + kstep, voffA); PG8_STAGE(PG8_SB(1, 1), cB + hstep + kstep, voffB);
        PG8_WAIT_V(6); PG8_BAR;
    } else {
        PG8_STAGE(PG8_SB(0, 0), cB, voffB); PG8_STAGE(PG8_SA(0, 0), cA, voffA); PG8_STAGE(PG8_SB(0, 1), cB + hstep, voffB); PG8_STAGE(PG8_SA(0, 1), cA + hstep, voffA);
        if (wr == 1) PG8_BAR;
        PG8_WAIT_V(4); PG8_BAR;
        PG8_STAGE(PG8_SB(1, 0), cB + kstep, voffB); PG8_STAGE(PG8_SA(1, 0), cA + kstep, voffA); PG8_STAGE(PG8_SB(1, 1), cB + hstep + kstep, voffB);
        PG8_WAIT_V(6); PG8_BAR;
    }
    for (;;) {
        const bool has_next = S.next(ui + 1, nxt);
        const char* nA = has_next ? PG8_ABASE(nxt.pm) : cA; const char* nB = has_next ? (const char*)g.Bt + (size_t)nxt.pn * tstep : cB;
        for (int t = 0; t < nt; t += 2) {
            const bool last = (t == nt - 2);
            const char* a1 = cA + (size_t)(t + 1) * kstep;
            const char* a2 = last ? nA : cA + (size_t)(t + 2) * kstep; const char* b2 = last ? nB : cB + (size_t)(t + 2) * kstep;
            const char* a3 = a2 + kstep; const char* b3 = b2 + kstep;
            if (last && has_next) S.a_ready(nxt);
            if constexpr (SP2) {
            PG8_LDB(B0, 0, 0); PG8_LDB(B1, 0, 1); PG8_SCHED; PG8_LDA(At, 0, 0); PG8_STAGE(PG8_SA(1, 1), a1 + hstep, voffA);
            PG8_WAIT_V(8); PG8_WAIT_L(0); PG8_BAR; PG8_MMA(0, 0, At, B0); PG8_MMA(0, 1, At, B1); PG8_BAR; PG8_SCHED;
            PG8_LDA(At, 0, 1); PG8_STAGE(PG8_SB(0, 0), b2, voffB); PG8_STAGE(PG8_SB(0, 1), b2 + hstep, voffB); PG8_STAGE(PG8_SA(0, 0), a2, voffA);
            PG8_WAIT_V(8); PG8_WAIT_L(0); PG8_BAR; PG8_MMA(1, 0, At, B0); PG8_MMA(1, 1, At, B1); PG8_BAR; PG8_SCHED;
            PG8_LDB(B0, 1, 0); PG8_LDB(B1, 1, 1); PG8_SCHED; PG8_LDA(At, 1, 0); PG8_STAGE(PG8_SA(0, 1), a2 + hstep, voffA);
            PG8_WAIT_V(8); PG8_WAIT_L(0); PG8_BAR; PG8_MMA(0, 0, At, B0); PG8_MMA(0, 1, At, B1); PG8_BAR; PG8_SCHED;
            PG8_LDA(At, 1, 1); PG8_STAGE(PG8_SB(1, 0), b3, voffB); PG8_STAGE(PG8_SB(1, 1), b3 + hstep, voffB); PG8_STAGE(PG8_SA(1, 0), a3, voffA);
            PG8_WAIT_V(8); PG8_WAIT_L(0); PG8_BAR; PG8_MMA(1, 0, At, B0); PG8_MMA(1, 1, At, B1); PG8_BAR; PG8_SCHED;
            } else {
            PG8_LDB(B0, 0, 0); PG8_SCHED; PG8_LDA(At, 0, 0); PG8_STAGE(PG8_SA(1, 1), a1 + hstep, voffA);
            PG8_WAIT_L(8); PG8_BAR; PG8_WAIT_L(0); PG8_MMA(0, 0, At, B0); PG8_BAR; PG8_SCHED;
            PG8_LDB(B1, 0, 1); PG8_STAGE(PG8_SB(0, 0), b2, voffB);
            PG8_BAR; PG8_WAIT_L(0); PG8_MMA(0, 1, At, B1); PG8_BAR;
            PG8_LDA(At, 0, 1); PG8_STAGE(PG8_SA(0, 0), a2, voffA);
            PG8_BAR; PG8_WAIT_L(0); PG8_MMA(1, 0, At, B0); PG8_BAR; PG8_SCHED;
            PG8_STAGE(PG8_SB(0, 1), b2 + hstep, voffB);
            PG8_WAIT_V(6); PG8_BAR; PG8_MMA(1, 1, At, B1); PG8_BAR;
            PG8_LDB(B0, 1, 0); PG8_SCHED; PG8_LDA(At, 1, 0); PG8_STAGE(PG8_SA(0, 1), a2 + hstep, voffA);
            PG8_WAIT_L(8); PG8_BAR; PG8_WAIT_L(0); PG8_MMA(0, 0, At, B0); PG8_BAR; PG8_SCHED;
            PG8_LDB(B1, 1, 1); PG8_STAGE(PG8_SB(1, 0), b3, voffB);
            PG8_BAR; PG8_WAIT_L(0); PG8_MMA(0, 1, At, B1); PG8_BAR;
            PG8_LDA(At, 1, 1); PG8_STAGE(PG8_SA(1, 0), a3, voffA);
            PG8_BAR; PG8_WAIT_L(0); PG8_MMA(1, 0, At, B0); PG8_BAR; PG8_SCHED;
            PG8_STAGE(PG8_SB(1, 1), b3 + hstep, voffB);
            PG8_WAIT_V(6); PG8_BAR; PG8_MMA(1, 1, At, B1); PG8_BAR;
            }
        }
        if constexpr (ALIGN_EPI) { if (wr == 0) PG8_BAR; }
        if constexpr (!Epi::AFTER_DRAIN) { E(acc, cur, wr, wc, fr, fq); S.done(cur); }
        if (!has_next) break;
#pragma unroll
        for (int a = 0; a < 2; ++a)
#pragma unroll
            for (int b = 0; b < 2; ++b)
#pragma unroll
                for (int m = 0; m < 4; ++m)
#pragma unroll
                    for (int n = 0; n < 2; ++n) acc[a][b][m][n] = (f32x4){0.f, 0.f, 0.f, 0.f};
        cur = nxt; cA = nA; cB = nB; ++ui;
        if constexpr (ALIGN_EPI) { if (wr == 1) PG8_BAR; }
    }
    PG8_WAIT_V(0);
    if constexpr (!ALIGN_EPI) { if (wr == 0) PG8_BAR; }
    PG8_BAR;
    if constexpr (Epi::AFTER_DRAIN) { E.fused(acc, cur, wr, wc, fr, fq, lds, wid, lane); S.done(cur); }
#undef PG8_SA
#undef PG8_SB
#undef PG8_STAGE
#undef PG8_LDA
#undef PG8_LDB
#undef PG8_MMA
#undef PG8_WAIT_V
#undef PG8_WAIT_L
#undef PG8_BAR
#undef PG8_SCHED
}
}

constexpr int DM = 1024, NSEQ = 6, SEQ = 8192, NMETA = 16, LTOT = SEQ + NMETA;
constexpr int MREAL = NSEQ * SEQ;
constexpr int MPAD = MREAL + 256;
constexpr int NPROMPT_ROWS = 2 * SEQ;
constexpr int NIN = 9216, NIN1 = 5120, NIN2 = 4096, DFF = 4096;
constexpr float EPS = 1e-6f;
constexpr size_t MiB = 1u << 20;
constexpr size_t UP = (size_t)MPAD * DM * 2;
constexpr size_t UR = (size_t)MREAL * DM * 2;
constexpr size_t WS_WINT = 1 * MiB;
constexpr size_t WS_W1T = 1 * MiB, WS_W2T = 9 * MiB;
constexpr size_t WS_SMALL = 20 * MiB;
constexpr size_t WS_RSTDO = 21 * MiB;
constexpr size_t WS_WAT = 23 * MiB, WS_WBT = 25 * MiB, WS_WOT = 27 * MiB;
constexpr size_t WS_R0 = 29 * MiB;
constexpr size_t WS_XA = WS_R0, WS_Q = WS_R0 + UP, WS_GF = WS_R0 + 2 * UP, WS_GB = WS_R0 + 3 * UP, WS_V = WS_R0 + 4 * UP;
constexpr size_t WS_A0B = WS_R0, WS_BRA = WS_R0 + UR, WS_BRB = WS_R0 + 2 * UR, WS_SGA = WS_R0 + 3 * UR, WS_SGB = WS_R0 + 4 * UR;
constexpr size_t WS_X1 = WS_R0, WS_A1 = WS_R0 + 2 * UR, WS_HHI = WS_R0 + 3 * UR;
constexpr size_t WS_END = WS_R0 + 5 * UP;
static_assert(WS_END <= 512 * MiB, "workspace map");
constexpr int HSPLIT_PM = MREAL / 256 / 2;

typedef unsigned short bf16;
typedef float f32x4 __attribute__((ext_vector_type(4)));
typedef unsigned u32x4 __attribute__((ext_vector_type(4)));
typedef unsigned u32x2 __attribute__((ext_vector_type(2)));

struct Args { const float* in[21]; float* out; unsigned char* ws; };

__device__ __forceinline__ float bf2f(unsigned v) { return __uint_as_float(v << 16); }
__device__ __forceinline__ unsigned f2bf(float f) { unsigned u = __float_as_uint(f); return (u + 0x7fffu + ((u >> 16) & 1u)) >> 16; }
__device__ __forceinline__ unsigned pk2(float lo, float hi) { return f2bf(lo) | (f2bf(hi) << 16); }
__device__ __forceinline__ float fsigmoid(float x) { return __builtin_amdgcn_rcpf(1.f + __expf(-x)); }
__device__ __forceinline__ float wave_sum(float v) {
#pragma unroll
    for (int o = 1; o < 64; o <<= 1) v += __shfl_xor(v, o);
    return v;
}
__device__ __forceinline__ void unpack8(u32x4 w, float (&o)[8]) {
    o[0] = __uint_as_float(w.x << 16); o[1] = __uint_as_float(w.x & 0xffff0000u); o[2] = __uint_as_float(w.y << 16); o[3] = __uint_as_float(w.y & 0xffff0000u);
    o[4] = __uint_as_float(w.z << 16); o[5] = __uint_as_float(w.z & 0xffff0000u); o[6] = __uint_as_float(w.w << 16); o[7] = __uint_as_float(w.w & 0xffff0000u);
}
__device__ __forceinline__ u32x4 pack8(const float (&v)[8]) {
    u32x4 w; w.x = pg8::cvt_pk_bf16(v[0], v[1]); w.y = pg8::cvt_pk_bf16(v[2], v[3]); w.z = pg8::cvt_pk_bf16(v[4], v[5]); w.w = pg8::cvt_pk_bf16(v[6], v[7]); return w;
}
__device__ __forceinline__ const float* xrow_ptr(const Args& a, int r) { return r < NPROMPT_ROWS ? a.in[0] + (size_t)r * DM : a.in[1] + (size_t)(r - NPROMPT_ROWS) * DM; }

struct FP1 { bf16* base; const float* lb;
    __device__ __forceinline__ void operator()(int row, int col, f32x4 v0, f32x4 v1) const {
        const int cg = col >> 10, c = col & 1023;
        float v[8] = {v0[0], v0[1], v0[2], v0[3], v1[0], v1[1], v1[2], v1[3]};
        if (cg == 1) {
#pragma unroll
            for (int j = 0; j < 8; ++j) v[j] = v[j] * fsigmoid(v[j]);
        } else if (cg == 2 || cg == 3) {
            const float* l = lb + (cg - 2) * DM + c; const f32x4 l0 = *(const f32x4*)l, l1 = *(const f32x4*)(l + 4);
            const float lv[8] = {l0[0], l0[1], l0[2], l0[3], l1[0], l1[1], l1[2], l1[3]};
#pragma unroll
            for (int j = 0; j < 8; ++j) v[j] = __logf(lv[j] + (1.f - lv[j]) * fsigmoid(v[j]));
        }
        *(u32x4*)(base + (size_t)cg * (UP / 2) + (size_t)row * DM + c) = pack8(v);
    }
};
struct FP3a { const bf16* hro; const float* rstdo; const float* hgg; bf16* out;
    __device__ __forceinline__ void operator()(int row, int col, f32x4 v0, f32x4 v1) const {
        const int cg = col >> 10, c = col & 1023;
        float v[8] = {v0[0], v0[1], v0[2], v0[3], v1[0], v1[1], v1[2], v1[3]};
        if (cg == 0) {
            float h[8]; unpack8(*(const u32x4*)(hro + (size_t)row * 2048 + c), h);
#pragma unroll
            for (int j = 0; j < 8; ++j) { const float x = v[j]; v[j] = h[j] * x * fsigmoid(1.5957691216057308f * (x + 0.044715f * x * x * x)); }
        } else if (cg == 1) {
            float o[8]; unpack8(*(const u32x4*)(hro + (size_t)row * 2048 + 1024 + c), o);
            const float rs = rstdo[(size_t)row * 8 + (c >> 7)];
            const f32x4 g0 = *(const f32x4*)(hgg + c), g1 = *(const f32x4*)(hgg + c + 4);
            const float gv[8] = {g0[0], g0[1], g0[2], g0[3], g1[0], g1[1], g1[2], g1[3]};
#pragma unroll
            for (int j = 0; j < 8; ++j) v[j] = o[j] * rs * gv[j] * (v[j] * fsigmoid(v[j]));
        } else {
#pragma unroll
            for (int j = 0; j < 8; ++j) v[j] = fsigmoid(v[j]);
        }
        *(u32x4*)(out + (size_t)cg * (UR / 2) + (size_t)row * DM + c) = pack8(v);
    }
};
struct FP3b1 { const bf16* sg; bf16* t1;
    __device__ __forceinline__ void operator()(int row, int col, f32x4 v0, f32x4 v1) const {
        float v[8] = {v0[0], v0[1], v0[2], v0[3], v1[0], v1[1], v1[2], v1[3]}; float s[8]; unpack8(*(const u32x4*)(sg + (size_t)row * DM + col), s);
#pragma unroll
        for (int j = 0; j < 8; ++j) v[j] *= s[j];
        *(u32x4*)(t1 + (size_t)row * DM + col) = pack8(v);
    }
};
struct FP3b2 { const bf16* sg; bf16* t1;
    __device__ __forceinline__ void operator()(int row, int col, f32x4 v0, f32x4 v1) const {
        float v[8] = {v0[0], v0[1], v0[2], v0[3], v1[0], v1[1], v1[2], v1[3]}; float s[8], t[8];
        unpack8(*(const u32x4*)(sg + (size_t)row * DM + col), s); unpack8(*(const u32x4*)(t1 + (size_t)row * DM + col), t);
#pragma unroll
        for (int j = 0; j < 8; ++j) v[j] = t[j] + v[j] * s[j];
        *(u32x4*)(t1 + (size_t)row * DM + col) = pack8(v);
    }
};
struct FP3c { const float* xp; const float* xs; float* x1;
    __device__ __forceinline__ void operator()(int row, int col, f32x4 v0, f32x4 v1) const {
        const float* xr = (row < NPROMPT_ROWS ? xp + (size_t)row * DM : xs + (size_t)(row - NPROMPT_ROWS) * DM) + col;
        float* o = x1 + (size_t)row * DM + col;
        *(f32x4*)o = *(const f32x4*)xr + v0; *(f32x4*)(o + 4) = *(const f32x4*)(xr + 4) + v1;
    }
};
struct FP4 { bf16* hlo; bf16* hhi;
    __device__ __forceinline__ void operator()(int row, int col, f32x4 v0, f32x4 v1) const {
        float v[8] = {v0[0], v0[1], v0[2], v0[3], v1[0], v1[1], v1[2], v1[3]};
#pragma unroll
        for (int j = 0; j < 8; ++j) { const float r = fmaxf(v[j], 0.f); v[j] = r * r; }
        bf16* o = row < HSPLIT_PM * 256 ? hlo + (size_t)row * DFF : hhi + (size_t)(row - HSPLIT_PM * 256) * DFF;
        *(u32x4*)(o + col) = pack8(v);
    }
};
struct FP5 { float* x1;
    __device__ __forceinline__ void operator()(int row, int col, f32x4 v0, f32x4 v1) const {
        float* o = x1 + (size_t)row * DM + col;
        *(f32x4*)o = *(const f32x4*)o + v0; *(f32x4*)(o + 4) = *(const f32x4*)(o + 4) + v1;
    }
};

template <int PH> __global__ void __launch_bounds__(512, 2) k_gemm(Args a) {
    extern __shared__ __attribute__((aligned(16))) unsigned char lds[];
    PG8_LAS unsigned char* L = (PG8_LAS unsigned char*)lds;
    unsigned char* ws = a.ws; bf16* outb = (bf16*)a.out;
    pg8::StaticOrder S;
    constexpr int NOSPLIT = 1 << 30;
    if constexpr (PH == 1) {
        pg8::Gemm g{outb, (const bf16*)(ws + WS_WINT), MPAD, NIN1, DM, outb, NOSPLIT}; S.init(MPAD, NIN1, gridDim.x, blockIdx.x);
        pg8::EpiRow8<FP1> E{{(bf16*)(ws + WS_XA), (const float*)(ws + WS_SMALL)}};
        pg8::gemm_phase<pg8::EpiRow8<FP1>, pg8::StaticOrder, true, true>(L, g, S, E);
    } else if constexpr (PH == 3) {
        pg8::Gemm g{(const bf16*)(ws + WS_A0B), (const bf16*)(ws + WS_WINT) + (size_t)NIN1 * DM, MREAL, NIN2, DM, (const bf16*)(ws + WS_A0B), NOSPLIT}; S.init(MREAL, NIN2, gridDim.x, blockIdx.x);
        pg8::EpiRow8<FP3a> E{{outb, (const float*)(ws + WS_RSTDO), a.in[13], (bf16*)(ws + WS_BRA)}};
        pg8::gemm_phase<pg8::EpiRow8<FP3a>, pg8::StaticOrder, true, true>(L, g, S, E);
    } else if constexpr (PH == 4) {
        pg8::Gemm g{(const bf16*)(ws + WS_BRA), (const bf16*)(ws + WS_WAT), MREAL, DM, DM, (const bf16*)(ws + WS_BRA), NOSPLIT}; S.init(MREAL, DM, gridDim.x, blockIdx.x);
        pg8::EpiRow8<FP3b1> E{{(const bf16*)(ws + WS_SGA), outb}};
        pg8::gemm_phase<pg8::EpiRow8<FP3b1>, pg8::StaticOrder, true, true>(L, g, S, E);
    } else if constexpr (PH == 5) {
        pg8::Gemm g{(const bf16*)(ws + WS_BRB), (const bf16*)(ws + WS_WBT), MREAL, DM, DM, (const bf16*)(ws + WS_BRB), NOSPLIT}; S.init(MREAL, DM, gridDim.x, blockIdx.x);
        pg8::EpiRow8<FP3b2> E{{(const bf16*)(ws + WS_SGB), outb}};
        pg8::gemm_phase<pg8::EpiRow8<FP3b2>, pg8::StaticOrder, true, true>(L, g, S, E);
    } else if constexpr (PH == 6) {
        pg8::Gemm g{outb, (const bf16*)(ws + WS_WOT), MREAL, DM, DM, outb, NOSPLIT}; S.init(MREAL, DM, gridDim.x, blockIdx.x);
        pg8::EpiRow8<FP3c> E{{a.in[0], a.in[1], (float*)(ws + WS_X1)}};
        pg8::gemm_phase<pg8::EpiRow8<FP3c>, pg8::StaticOrder, true, true>(L, g, S, E);
    } else if constexpr (PH == 7) {
        pg8::Gemm g{(const bf16*)(ws + WS_A1), (const bf16*)(ws + WS_W1T), MREAL, DFF, DM, (const bf16*)(ws + WS_A1), NOSPLIT}; S.init(MREAL, DFF, gridDim.x, blockIdx.x);
        pg8::EpiRow8<FP4> E{{outb, (bf16*)(ws + WS_HHI)}};
        pg8::gemm_phase<pg8::EpiRow8<FP4>, pg8::StaticOrder, true, true>(L, g, S, E);
    } else if constexpr (PH == 8) {
        pg8::Gemm g{outb, (const bf16*)(ws + WS_W2T), MREAL, DM, DFF, (const bf16*)(ws + WS_HHI), HSPLIT_PM}; S.init(MREAL, DM, gridDim.x, blockIdx.x);
        pg8::EpiRow8<FP5> E{{(float*)(ws + WS_X1)}};
        pg8::gemm_phase<pg8::EpiRow8<FP5>, pg8::StaticOrder, true, true>(L, g, S, E);
    }
}

__device__ __forceinline__ void transpose_item(const float* W, int K, int N, bf16* WT, int k0, int n0, int dst_row0, float* scr, int lane) {
#pragma unroll 8
    for (int i = 0; i < 32; ++i) { const int kk = 2 * i + (lane >> 5); scr[kk * 33 + (lane & 31)] = W[(size_t)(k0 + kk) * N + n0 + (lane & 31)]; }
    asm volatile("s_waitcnt lgkmcnt(0)" ::: "memory");
    const int c = lane & 7;
#pragma unroll
    for (int j = 0; j < 4; ++j) { const int n = (lane >> 3) + 8 * j; const float* s = scr + (8 * c) * 33 + n;
        u32x4 o; o.x = pk2(s[0 * 33], s[1 * 33]); o.y = pk2(s[2 * 33], s[3 * 33]); o.z = pk2(s[4 * 33], s[5 * 33]); o.w = pk2(s[6 * 33], s[7 * 33]);
        *(u32x4*)(WT + (size_t)(dst_row0 + n) * K + k0 + 8 * c) = o; }
    asm volatile("s_waitcnt lgkmcnt(0)" ::: "memory");
}
__device__ __forceinline__ void norm_row_bf16(const float* xrow, const float* gain, bf16* orow, int lane) {
    const f32x4* xr = (const f32x4*)xrow + lane; f32x4 v[4]; float s = 0.f;
#pragma unroll
    for (int j = 0; j < 4; ++j) { v[j] = xr[64 * j]; s += (v[j].x * v[j].x + v[j].y * v[j].y) + (v[j].z * v[j].z + v[j].w * v[j].w); }
    const float rstd = rsqrtf(wave_sum(s) * (1.f / DM) + EPS);
    u32x2* o8 = (u32x2*)orow + lane;
#pragma unroll
    for (int j = 0; j < 4; ++j) { const f32x4 g = ((const f32x4*)gain)[lane + 64 * j]; u32x2 w; w.x = pk2(v[j].x * rstd * g.x, v[j].y * rstd * g.y); w.y = pk2(v[j].z * rstd * g.z, v[j].w * rstd * g.w); o8[64 * j] = w; }
}
__device__ __forceinline__ int win_dst_group(int g) { return g == 0 ? 0 : g == 1 ? 5 : g <= 5 ? g - 1 : g; }

__global__ void __launch_bounds__(256) k_prep0(Args a) {
    __shared__ float scr_all[4 * 64 * 33];
    const int tid = threadIdx.x, lane = tid & 63, wave = tid >> 6; float* scr = scr_all + wave * 64 * 33;
    const int gw = blockIdx.x * 4 + wave, NGW = gridDim.x * 4; unsigned char* ws = a.ws;
    { const int g = blockIdx.x * 256 + tid; float* sm = (float*)(ws + WS_SMALL);
      if (g < 2048) { const float l0 = a.in[3][g], l1 = a.in[3][2048 + g]; const float m = fmaxf(l0, l1); const float e0 = expf(l0 - m), e1 = expf(l1 - m); sm[g] = e0 / (e0 + e1); }
      else if (g < 4096) { const float lam = a.in[12][g - 2048]; sm[g] = -8.f * log1pf(expf(-lam)); } }
    constexpr int I_WIN = (DM / 64) * (NIN / 32), I_SQ = (DM / 64) * (DM / 32);
    for (int it = gw; it < I_WIN + 3 * I_SQ; it += NGW) {
        int r = it;
        if (r < I_WIN) { const int nblk = NIN / 32, kb = r / nblk, nb = r % nblk, n0 = nb * 32; transpose_item(a.in[5], DM, NIN, (bf16*)(ws + WS_WINT), kb * 64, n0, win_dst_group(n0 >> 10) * 1024 + (n0 & 1023), scr, lane); continue; }
        r -= I_WIN; const int which = r / I_SQ; r %= I_SQ; const int nblk = DM / 32, kb = r / nblk, nb = r % nblk;
        transpose_item(a.in[14 + which], DM, DM, (bf16*)(ws + (which == 0 ? WS_WAT : which == 1 ? WS_WBT : WS_WOT)), kb * 64, nb * 32, nb * 32, scr, lane);
    }
    bf16* A0 = (bf16*)a.out;
    for (int m = gw; m < MPAD; m += NGW) {
        if (m < MREAL) norm_row_bf16(xrow_ptr(a, m), a.in[4], A0 + (size_t)m * DM, lane);
        else if (m < MREAL + NMETA) norm_row_bf16(a.in[2] + (size_t)(m - MREAL) * DM, a.in[4], A0 + (size_t)m * DM, lane);
        else { u32x4* o = (u32x4*)(A0 + (size_t)m * DM); o[lane] = (u32x4){0u, 0u, 0u, 0u}; o[lane + 64] = (u32x4){0u, 0u, 0u, 0u}; }
    }
}
__global__ void __launch_bounds__(256) k_prep2(Args a) {
    const int tid = threadIdx.x, lane = tid & 63, wave = tid >> 6; const int gw = blockIdx.x * 4 + wave, NGW = gridDim.x * 4; unsigned char* ws = a.ws;
    bf16* A0 = (bf16*)(ws + WS_A0B); const bf16* hro = (const bf16*)a.out; float* rstdo = (float*)(ws + WS_RSTDO);
    for (int m = gw; m < MREAL; m += NGW) {
        norm_row_bf16(xrow_ptr(a, m), a.in[4], A0 + (size_t)m * DM, lane);
        const u32x4* op = (const u32x4*)(hro + (size_t)m * 2048 + 1024) + 2 * lane; float o[8], p[8]; unpack8(op[0], o); unpack8(op[1], p); float ss = 0.f;
#pragma unroll
        for (int j = 0; j < 8; ++j) ss += o[j] * o[j] + p[j] * p[j];
        ss += __shfl_xor(ss, 1); ss += __shfl_xor(ss, 2); ss += __shfl_xor(ss, 4);
        if ((lane & 7) == 0) rstdo[(size_t)m * 8 + (lane >> 3)] = rsqrtf(ss * (1.f / 128.f) + EPS);
    }
}
__global__ void __launch_bounds__(256) k_prep3(Args a) {
    __shared__ float scr_all[4 * 64 * 33];
    const int tid = threadIdx.x, lane = tid & 63, wave = tid >> 6; float* scr = scr_all + wave * 64 * 33;
    const int gw = blockIdx.x * 4 + wave, NGW = gridDim.x * 4; unsigned char* ws = a.ws;
    constexpr int I_1 = (DM / 64) * (DFF / 32), I_2 = (DFF / 64) * (DM / 32);
    for (int it = gw; it < I_1 + I_2; it += NGW) {
        if (it < I_1) { const int nblk = DFF / 32, kb = it / nblk, nb = it % nblk; transpose_item(a.in[18], DM, DFF, (bf16*)(ws + WS_W1T), kb * 64, nb * 32, nb * 32, scr, lane); }
        else { const int r = it - I_1, nblk = DM / 32, kb = r / nblk, nb = r % nblk; transpose_item(a.in[19], DFF, DM, (bf16*)(ws + WS_W2T), kb * 64, nb * 32, nb * 32, scr, lane); }
    }
}
__global__ void __launch_bounds__(256) k_norm1(Args a) {
    const int tid = threadIdx.x, lane = tid & 63, wave = tid >> 6; const int gw = blockIdx.x * 4 + wave, NGW = gridDim.x * 4; unsigned char* ws = a.ws;
    for (int m = gw; m < MREAL; m += NGW) norm_row_bf16((const float*)(ws + WS_X1) + (size_t)m * DM, a.in[17], (bf16*)(ws + WS_A1) + (size_t)m * DM, lane);
}
__global__ void __launch_bounds__(256) k_final(Args a) {
    const int tid = threadIdx.x, lane = tid & 63, wave = tid >> 6; const int gw = blockIdx.x * 4 + wave, NGW = gridDim.x * 4; unsigned char* ws = a.ws;
    for (int m = gw; m < MREAL; m += NGW) {
        const f32x4* xr = (const f32x4*)((const float*)(ws + WS_X1) + (size_t)m * DM) + lane; f32x4 v[4]; float s = 0.f;
#pragma unroll
        for (int j = 0; j < 4; ++j) { v[j] = xr[64 * j]; s += (v[j].x * v[j].x + v[j].y * v[j].y) + (v[j].z * v[j].z + v[j].w * v[j].w); }
        const float rstd = rsqrtf(wave_sum(s) * (1.f / DM) + EPS);
        f32x4* o = (f32x4*)(a.out + (size_t)m * DM) + lane;
#pragma unroll
        for (int j = 0; j < 4; ++j) { const f32x4 g = ((const f32x4*)a.in[20])[lane + 64 * j]; o[64 * j] = v[j] * rstd * g; }
    }
}

__device__ __forceinline__ size_t in_row(int s, int p) { return p < NMETA ? (size_t)(MREAL + p) : (size_t)s * SEQ + (p - NMETA); }
__device__ __forceinline__ float xa_at(const bf16* XA, int s, int p, int C) { return (p < 0 || p >= LTOT) ? 0.f : bf2f(XA[in_row(s, p) * DM + C]); }

template <int DIR> __device__ __forceinline__ void rglru_sweep(const Args& a, float* Was, float* Wxs, float* xcs, int s, int h, int c) {
    const int C = h * 128 + c; unsigned char* ws = a.ws; const bf16* XA = (const bf16*)(ws + WS_XA); bf16* hro = (bf16*)a.out;
    const float cw0 = a.in[6][C], cw1 = a.in[6][DM + C], cw2 = a.in[6][2 * DM + C], cw3 = a.in[6][3 * DM + C], cb = a.in[7][C];
    __syncthreads();
    for (int i = c; i < 128 * 128; i += 128) { Was[i] = a.in[8][(size_t)(DIR * 8 + h) * 16384 + i]; Wxs[i] = a.in[10][(size_t)(DIR * 8 + h) * 16384 + i]; }
    const float ba = a.in[9][DIR * DM + C], bx = a.in[11][DIR * DM + C], cl = ((const float*)(ws + WS_SMALL))[2048 + DIR * DM + C];
    float hst = 0.f;
    const int ntile = DIR == 0 ? LTOT / 16 : SEQ / 16;
    for (int tl = 0; tl < ntile; ++tl) {
        const int p0 = DIR == 0 ? tl * 16 : LTOT - 16 * (tl + 1);
        float xv[19];
#pragma unroll
        for (int j = 0; j < 19; ++j) xv[j] = xa_at(XA, s, p0 - 2 + j, C);
        float xc[16];
#pragma unroll
        for (int t = 0; t < 16; ++t) xc[t] = cb + cw0 * xv[t] + cw1 * xv[t + 1] + cw2 * xv[t + 2] + cw3 * xv[t + 3];
        __syncthreads();
#pragma unroll
        for (int t = 0; t < 16; ++t) xcs[t * 128 + c] = xc[t];
        __syncthreads();
        float ra[16], rx[16];
#pragma unroll
        for (int t = 0; t < 16; ++t) { ra[t] = ba; rx[t] = bx; }
        for (int i = 0; i < 128; ++i) { const float wa = Was[i * 128 + c], wx = Wxs[i * 128 + c];
#pragma unroll
            for (int t = 0; t < 16; ++t) { const float xi = xcs[t * 128 + i]; ra[t] += xi * wa; rx[t] += xi * wx; } }
#pragma unroll
        for (int k = 0; k < 16; ++k) { const int t = DIR == 0 ? k : 15 - k;
            const float r = 1.f / (1.f + expf(-ra[t])), ig = 1.f / (1.f + expf(-rx[t])); const float la = cl * r; const float av = expf(la), mult = sqrtf(-expm1f(2.f * la));
            hst = av * hst + mult * (ig * xc[t]);
            const int p = p0 + t;
            if (p >= NMETA) { bf16* dst = hro + ((size_t)s * SEQ + (p - NMETA)) * 2048 + C; if (DIR == 1) *dst = (bf16)f2bf(hst); else *dst = (bf16)f2bf(bf2f(*dst) + hst); } }
    }
}
__global__ void __launch_bounds__(128) k_rglru_naive(Args a) {
    extern __shared__ __attribute__((aligned(16))) unsigned char lds[];
    float* Was = (float*)lds; float* Wxs = Was + 16384; float* xcs = Wxs + 16384;
    const int s = blockIdx.x / 8, h = blockIdx.x % 8, c = threadIdx.x;
    rglru_sweep<1>(a, Was, Wxs, xcs, s, h, c);
    rglru_sweep<0>(a, Was, Wxs, xcs, s, h, c);
}

template <int DIR> __device__ __forceinline__ void hgrn_sweep(const Args& a, float (*qs)[128], float (*fs)[128], float (*ks)[128], int s, int hd, int j) {
    const int C = hd * 128 + j; unsigned char* ws = a.ws; bf16* hro = (bf16*)a.out;
    const bf16* Q = (const bf16*)(ws + WS_Q); const bf16* G = (const bf16*)(ws + (DIR == 0 ? WS_GF : WS_GB)); const bf16* V = (const bf16*)(ws + WS_V);
    float S[128];
#pragma unroll
    for (int k = 0; k < 128; ++k) S[k] = 0.f;
    const int nsteps = DIR == 0 ? LTOT : SEQ;
    size_t r0 = in_row(s, DIR == 0 ? 0 : LTOT - 1);
    float nq = bf2f(Q[r0 * DM + C]), ng = bf2f(G[r0 * DM + C]), nv = bf2f(V[r0 * DM + C]);
    for (int st = 0; st < nsteps; ++st) {
        const int p = DIR == 0 ? st : LTOT - 1 - st; const int buf = st & 1;
        const float qv = nq, gv = ng, vv = nv;
        if (st + 1 < nsteps) { const size_t rn = in_row(s, DIR == 0 ? p + 1 : p - 1); nq = bf2f(Q[rn * DM + C]); ng = bf2f(G[rn * DM + C]); nv = bf2f(V[rn * DM + C]); }
        qs[buf][j] = qv; fs[buf][j] = expf(gv); ks[buf][j] = -expm1f(gv);
        __syncthreads();
        float o = 0.f;
#pragma unroll
        for (int k = 0; k < 128; ++k) { S[k] = fs[buf][k] * S[k] + ks[buf][k] * vv; o += qs[buf][k] * S[k]; }
        if (p >= NMETA) { bf16* dst = hro + ((size_t)s * SEQ + (p - NMETA)) * 2048 + 1024 + C; if (DIR == 1) *dst = (bf16)f2bf(o); else *dst = (bf16)f2bf(bf2f(*dst) + o); }
    }
}
__global__ void __launch_bounds__(128) k_hgrn_naive(Args a) {
    __shared__ float qs[2][128], fs[2][128], ks[2][128];
    const int s = blockIdx.x / 8, hd = blockIdx.x % 8, j = threadIdx.x;
    hgrn_sweep<1>(a, qs, fs, ks, s, hd, j);
    __syncthreads();
    hgrn_sweep<0>(a, qs, fs, ks, s, hd, j);
}

extern "C" void kernel_launch(void* const* d_in, const int* in_sizes, int n_in, void* d_out, int out_size, void* d_ws, size_t ws_size, hipStream_t stream) {
    static int ready = 0;
    constexpr int GEMM_LDS = 131072, RG_LDS = (2 * 16384 + 16 * 128) * 4;
    if (ready == 0) {
        if (n_in != 21 || out_size != MREAL * DM || ws_size < WS_END) { fprintf(stderr, "kernel_launch: unexpected shapes (n_in %d, out %d, ws %zu)\n", n_in, out_size, ws_size); ready = -1; return; }
        hipError_t e = hipSuccess;
#define SETLDS(k, n) do { hipError_t e_ = hipFuncSetAttribute((const void*)(k), hipFuncAttributeMaxDynamicSharedMemorySize, (n)); if (e_ != hipSuccess) e = e_; } while (0)
        SETLDS(k_gemm<1>, GEMM_LDS); SETLDS(k_gemm<3>, GEMM_LDS); SETLDS(k_gemm<4>, GEMM_LDS); SETLDS(k_gemm<5>, GEMM_LDS); SETLDS(k_gemm<6>, GEMM_LDS); SETLDS(k_gemm<7>, GEMM_LDS); SETLDS(k_gemm<8>, GEMM_LDS);
        SETLDS(k_rglru_naive, RG_LDS);
#undef SETLDS
        if (e != hipSuccess) { fprintf(stderr, "kernel_launch: hipFuncSetAttribute failed: %s\n", hipGetErrorString(e)); ready = -1; return; }
        ready = 1;
    }
    if (ready < 0) return;
    Args a{};
    for (int i = 0; i < 21; ++i) a.in[i] = (const float*)d_in[i];
    a.out = (float*)d_out; a.ws = (unsigned char*)d_ws;
    const int G = 256;
    k_prep0<<<1024, 256, 0, stream>>>(a);
    k_gemm<1><<<G, 512, GEMM_LDS, stream>>>(a);
    k_rglru_naive<<<NSEQ * 8, 128, RG_LDS, stream>>>(a);
    k_hgrn_naive<<<NSEQ * 8, 128, 0, stream>>>(a);
    k_prep2<<<1024, 256, 0, stream>>>(a);
    k_gemm<3><<<G, 512, GEMM_LDS, stream>>>(a);
    k_prep3<<<1024, 256, 0, stream>>>(a);
    k_gemm<4><<<G, 512, GEMM_LDS, stream>>>(a);
    k_gemm<5><<<G, 512, GEMM_LDS, stream>>>(a);
    k_gemm<6><<<G, 512, GEMM_LDS, stream>>>(a);
    k_norm1<<<1024, 256, 0, stream>>>(a);
    k_gemm<7><<<G, 512, GEMM_LDS, stream>>>(a);
    k_gemm<8><<<G, 512, GEMM_LDS, stream>>>(a);
    k_final<<<1024, 256, 0, stream>>>(a);
}
```

```cpp
#include <hip/hip_runtime.h>
#include <cstdio>
#include <cstdint>
namespace pg8 {
#define PG8_LAS __attribute__((address_space(3)))
typedef unsigned short bf16_t;
typedef short bf16x8 __attribute__((ext_vector_type(8)));
typedef float f32x4 __attribute__((ext_vector_type(4)));
typedef unsigned u32x4 __attribute__((ext_vector_type(4)));
constexpr int BM = 256, BK = 64, HALF = 128, HTB = HALF * BK * 2  , STAGE_BYTES = 8 * HTB, NXCD = 8, WGM = 8;

__host__ __device__ __forceinline__ int lds_byte(int r, int c) { const int st = (r >> 4) * 2 + (c >> 5), rr = r & 15, cc = c & 31, ob = rr * 64 + cc * 2; return st * 1024 + (ob ^ (((ob >> 9) & 1) << 5)); }
__host__ __device__ __forceinline__ void stage_rc(int b, int& R, int& C) { const int st = b / 1024, sb = b % 1024, swz = sb ^ (((sb >> 9) & 1) << 5); R = (st >> 1) * 16 + swz / 64; C = (st & 1) * 32 + (swz % 64) / 2; }
__host__ __device__ __forceinline__ int perm32(int rho) { const int n = rho >> 4, i = rho & 15; return 8 * (i >> 2) + 4 * n + (i & 3); }

struct Unit { int pm, pn; };
struct Gemm { const bf16_t* A; const bf16_t* Bt; int M, N, K; const bf16_t* A2; int pm_split; };

struct StaticOrder {
    int nM, nN, nwg, G, c;
    __host__ __device__ void init(int M, int N, int G_, int c_) { nM = M / BM; nN = N / BM; nwg = nM * nN; G = G_; c = c_; }
    __host__ __device__ bool next(int i, Unit& u) const {
        const long L = (long)i * G + c; if (L >= nwg) return false;
        int wgid = (int)L; { const int q = nwg / NXCD, r = nwg % NXCD, xcd = wgid % NXCD, off = wgid / NXCD; wgid = (xcd < r ? xcd * (q + 1) : r * (q + 1) + (xcd - r) * q) + off; }
        const int nig = WGM * nN, gid = wgid / nig, fm = gid * WGM, gsz = (nM - fm) < WGM ? (nM - fm) : WGM;
        u.pm = fm + ((wgid % nig) % gsz); u.pn = (wgid % nig) / gsz; return true;
    }
    __device__ __forceinline__ void a_ready(const Unit&) const {}
    __device__ __forceinline__ void done(const Unit&) const {}
};

typedef float f32x2v __attribute__((ext_vector_type(2)));
typedef __bf16 bf16x2v __attribute__((ext_vector_type(2)));
__device__ __forceinline__ unsigned cvt_pk_bf16(float lo, float hi) { const f32x2v f = {lo, hi}; const bf16x2v b = __builtin_convertvector(f, bf16x2v); return __builtin_bit_cast(unsigned, b); }
typedef float f32x2 __attribute__((ext_vector_type(2)));
template <class F> struct EpiRow8 {
    static constexpr bool PERM = true, AFTER_DRAIN = false; F f;
    __device__ __forceinline__ void operator()(const f32x4 (&acc)[2][2][4][2], const Unit& u, int wr, int wc, int fr, int fq) const {
        const int row0 = u.pm * BM + wr * 64 + fr, col0 = u.pn * BM + wc * 32 + 8 * fq;
#pragma unroll
        for (int ai = 0; ai < 2; ++ai)
#pragma unroll
            for (int m = 0; m < 4; ++m) {
#pragma unroll
                for (int bj = 0; bj < 2; ++bj) f(row0 + ai * HALF + m * 16, col0 + bj * HALF, acc[ai][bj][m][0], acc[ai][bj][m][1]);
                if (m & 1) asm volatile("" ::: "memory"); }
    }
};
#define PG8_ABASE(pm) ((pm) < g.pm_split ? (const char*)g.A + (size_t)(pm) * tstep : (const char*)g.A2 + (size_t)((pm) - g.pm_split) * tstep)
template <class Epi, class Sched, bool ALIGN_EPI = false, bool SP2 = false>
__device__ __forceinline__ void gemm_phase(PG8_LAS unsigned char* lds, const Gemm g, const Sched& S, const Epi& E) {
    const int tid = threadIdx.x, wid = __builtin_amdgcn_readfirstlane(tid >> 6), lane = tid & 63, wr = wid >> 2, wc = wid & 3, fr = lane & 15, fq = lane >> 4;
    const int K = g.K, nt = K / BK;
    unsigned voffA[2], voffB[2];
#pragma unroll
    for (int i = 0; i < 2; ++i) { int R, C; stage_rc(tid * 16 + i * 8192, R, C); const int Rb = Epi::PERM ? ((R & ~31) + perm32(R & 31)) : R;
        voffA[i] = (unsigned)(R * K + C) * 2u; voffB[i] = (unsigned)(Rb * K + C) * 2u; }
    const size_t kstep = (size_t)(BK * 2);
    const size_t hstep = (size_t)HALF * K * 2;
    const size_t tstep = 2 * hstep;
    const unsigned ldsw = (unsigned)wid * 1024u;
    const int aoff = lds_byte(wr * 64 + fr, fq * 8), boff = lds_byte(wc * 32 + fr, fq * 8);
#define PG8_SA(b, h) (((b) * 2 + (h)) * HTB)
#define PG8_SB(b, h) ((4 + (b) * 2 + (h)) * HTB)
#define PG8_STAGE(bufoff, gbase, voff) do { _Pragma("unroll") for (int _i = 0; _i < 2; ++_i) \
        __builtin_amdgcn_global_load_lds((const unsigned*)((const char*)(gbase) + (voff)[_i]), (PG8_LAS unsigned*)(lds + (bufoff) + ldsw + _i * 8192), 16, 0, 0); } while (0)
#define PG8_LDA(dst, b, h) do { _Pragma("unroll") for (int m = 0; m < 4; ++m) _Pragma("unroll") for (int k = 0; k < 2; ++k) dst[m][k] = *(const PG8_LAS bf16x8*)(lds + PG8_SA(b, h) + aoff + m * 2048 + k * 1024); } while (0)
#define PG8_LDB(dst, b, h) do { _Pragma("unroll") for (int n = 0; n < 2; ++n) _Pragma("unroll") for (int k = 0; k < 2; ++k) dst[n][k] = *(const PG8_LAS bf16x8*)(lds + PG8_SB(b, h) + boff + n * 2048 + k * 1024); } while (0)
#define PG8_MMA(ai, bj, At, Bt) do { __builtin_amdgcn_s_setprio(1); _Pragma("unroll") for (int m = 0; m < 4; ++m) _Pragma("unroll") for (int n = 0; n < 2; ++n) _Pragma("unroll") for (int k = 0; k < 2; ++k) \
        acc[ai][bj][m][n] = __builtin_amdgcn_mfma_f32_16x16x32_bf16(Bt[n][k], At[m][k], acc[ai][bj][m][n], 0, 0, 0); __builtin_amdgcn_s_setprio(0); } while (0)
#define PG8_WAIT_V(n) asm volatile("s_waitcnt vmcnt(" #n ")" ::: "memory")
#define PG8_WAIT_L(n) asm volatile("s_waitcnt lgkmcnt(" #n ")" ::: "memory")
#define PG8_BAR __builtin_amdgcn_s_barrier()
#define PG8_SCHED __builtin_amdgcn_sched_barrier(0)
    Unit cur, nxt; int ui = 0;
    if (!S.next(0, cur)) return;
    f32x4 acc[2][2][4][2];
#pragma unroll
    for (int a = 0; a < 2; ++a)
#pragma unroll
        for (int b = 0; b < 2; ++b)
#pragma unroll
            for (int m = 0; m < 4; ++m)
#pragma unroll
                for (int n = 0; n < 2; ++n) acc[a][b][m][n] = (f32x4){0.f, 0.f, 0.f, 0.f};
    bf16x8 At[4][2], B0[2][2], B1[2][2];
    const char* cA = PG8_ABASE(cur.pm); const char* cB = (const char*)g.Bt + (size_t)cur.pn * tstep;
    S.a_ready(cur);
    if constexpr (SP2) {
        PG8_STAGE(PG8_SB(0, 0), cB, voffB); PG8_STAGE(PG8_SB(0, 1), cB + hstep, voffB); PG8_STAGE(PG8_SA(0, 0), cA, voffA); PG8_STAGE(PG8_SA(0, 1), cA + hstep, voffA);
        if (wr == 1) PG8_BAR;
        PG8_WAIT_V(2); PG8_BAR;
        PG8_STAGE(PG8_SB(1, 0), cB + kstep, voffB); PG8_STAGE(PG8_SA(1, 0), cA + kstep, voffA); PG8_STAGE(PG8_SB(1, 1), cB + hstep + kstep, voffB);
        PG8_WAIT_V(6); PG8_BAR;
    } else {
        PG8_STAGE(PG8_SB(0, 0), cB, voffB); PG8_STAGE(PG8_SA(0, 0), cA, voffA); PG8_STAGE(PG8_SB(0, 1), cB + hstep, voffB); PG8_STAGE(PG8_SA(0, 1), cA + hstep, voffA);
        if (wr == 1) PG8_BAR;
        PG8_WAIT_V(4); PG8_BAR;
        PG8_STAGE(PG8_SB(1, 0), cB + kstep, voffB); PG8_STAGE(PG8_SA(1, 0), cA + kstep, voffA); PG8_STAGE(PG8_SB(1, 1), cB + hstep + kstep, voffB);
        PG8_WAIT_V(6); PG8_BAR;
    }
    for (;;) {
        const bool has_next = S.next(ui + 1, nxt);
        const char* nA = has_next ? PG8_ABASE(nxt.pm) : cA; const char* nB = has_next ? (const char*)g.Bt + (size_t)nxt.pn * tstep : cB;
        for (int t = 0; t < nt; t += 2) {
            const bool last = (t == nt - 2);
            const char* a1 = cA + (size_t)(t + 1) * kstep;
            const char* a2 = last ? nA : cA + (size_t)(t + 2) * kstep; const char* b2 = last ? nB : cB + (size_t)(t + 2) * kstep;
            const char* a3 = a2 + kstep; const char* b3 = b2 + kstep;
            if (last && has_next) S.a_ready(nxt);
            if constexpr (SP2) {
            PG8_LDB(B0, 0, 0); PG8_LDB(B1, 0, 1); PG8_SCHED; PG8_LDA(At, 0, 0); PG8_STAGE(PG8_SA(1, 1), a1 + hstep, voffA);
            PG8_WAIT_V(8); PG8_WAIT_L(0); PG8_BAR; PG8_MMA(0, 0, At, B0); PG8_MMA(0, 1, At, B1); PG8_BAR; PG8_SCHED;
            PG8_LDA(At, 0, 1); PG8_STAGE(PG8_SB(0, 0), b2, voffB); PG8_STAGE(PG8_SB(0, 1), b2 + hstep, voffB); PG8_STAGE(PG8_SA(0, 0), a2, voffA);
            PG8_WAIT_V(8); PG8_WAIT_L(0); PG8_BAR; PG8_MMA(1, 0, At, B0); PG8_MMA(1, 1, At, B1); PG8_BAR; PG8_SCHED;
            PG8_LDB(B0, 1, 0); PG8_LDB(B1, 1, 1); PG8_SCHED; PG8_LDA(At, 1, 0); PG8_STAGE(PG8_SA(0, 1), a2 + hstep, voffA);
            PG8_WAIT_V(8); PG8_WAIT_L(0); PG8_BAR; PG8_MMA(0, 0, At, B0); PG8_MMA(0, 1, At, B1); PG8_BAR; PG8_SCHED;
            PG8_LDA(At, 1, 1); PG8_STAGE(PG8_SB(1, 0), b3, voffB); PG8_STAGE(PG8_SB(1, 1), b3 + hstep, voffB); PG8_STAGE(PG8_SA(1, 0), a3, voffA);
            PG8_WAIT_V(8); PG8_WAIT_L(0); PG8_BAR; PG8_MMA(1, 0, At, B0); PG8_MMA(1, 1, At, B1); PG8_BAR; PG8_SCHED;
            } else {
            PG8_LDB(B0, 0, 0); PG8_SCHED; PG8_LDA(At, 0, 0); PG8_STAGE(PG8_SA(1, 1), a1 + hstep, voffA);
            PG8_WAIT_L(8); PG8_BAR; PG8_WAIT_L(0); PG8_MMA(0, 0, At, B0); PG8_BAR; PG8_SCHED;
            PG8_LDB(B1, 0, 1); PG8_STAGE(PG8_SB(0, 0), b2, voffB);
            PG8_BAR; PG8_WAIT_L(0); PG8_MMA(0, 1, At, B1); PG8_BAR;
            PG8_LDA(At, 0, 1); PG8_STAGE(PG8_SA(0, 0), a2, voffA);
            PG8_BAR; PG8_WAIT_L(0); PG8_MMA(1, 0, At, B0); PG8_BAR; PG8_SCHED;
            PG8_STAGE(PG8_SB(0, 1), b2 + hstep, voffB);
            PG8_WAIT_V(6); PG8_BAR; PG8_MMA(1, 1, At, B1); PG8_BAR;
            PG8_LDB(B0, 1, 0); PG8_SCHED; PG8_LDA(At, 1, 0); PG8_STAGE(PG8_SA(0, 1), a2 + hstep, voffA);
            PG8_WAIT_L(8); PG8_BAR; PG8_WAIT_L(0); PG8_MMA(0, 0, At, B0); PG8_BAR; PG8_SCHED;
            PG8_LDB(B1, 1, 1); PG8_STAGE(PG8_SB(1, 0), b3, voffB);
            PG8_BAR; PG8_WAIT_L(0); PG8_MMA(0, 1, At, B1); PG8_BAR;
            PG8_LDA(At, 1, 1); PG8_STAGE(PG8_SA(1, 0), a3, voffA);
            PG8_BAR; PG8_WAIT_L(0); PG8_MMA(1, 0, At, B0); PG8_BAR; PG8_SCHED;
            PG8_STAGE(PG8_SB(1, 1), b3 + hstep, voffB);
            PG8_WAIT_V(6); PG8_BAR; PG8_MMA(1, 1, At, B1); PG8_BAR;
            }
        }
        if constexpr (ALIGN_EPI) { if (wr == 0) PG8_BAR; }
        if constexpr (!Epi::AFTER_DRAIN) { E(acc, cur, wr, wc, fr, fq); S.done(cur); }
        if (!has_next) break;
#pragma unroll
        for (int a = 0; a < 2; ++a)
#pragma unroll
            for (int b = 0; b < 2; ++b)
#pragma unroll
                for (int m = 0; m < 4; ++m)
#pragma unroll
                    for (int n = 0; n < 2; ++n) acc[a][b][m][n] = (f32x4){0.f, 0.f, 0.f, 0.f};
        cur = nxt; cA = nA; cB = nB; ++ui;
        if constexpr (ALIGN_EPI) { if (wr == 1) PG8_BAR; }
    }
    PG8_WAIT_V(0);
    if constexpr (!ALIGN_EPI) { if (wr == 0) PG8_BAR; }
    PG8_BAR;
    if constexpr (Epi::AFTER_DRAIN) { E.fused(acc, cur, wr, wc, fr, fq, lds, wid, lane); S.done(cur); }
#undef PG8_SA
#undef PG8_SB
#undef PG8_STAGE
#undef PG8_LDA
#undef PG8_LDB
#undef PG8_MMA
#undef PG8_WAIT_V
#undef PG8_WAIT_L
#undef PG8_BAR
#undef PG8_SCHED
}
}

constexpr int DM = 1024, NSEQ = 6, SEQ = 8192, NMETA = 16, LTOT = SEQ + NMETA;
constexpr int MREAL = NSEQ * SEQ;
constexpr int MPAD = MREAL + 256;
constexpr int NPROMPT_ROWS = 2 * SEQ;
constexpr int NIN = 9216, NIN1 = 5120, DFF = 4096;
constexpr float EPS = 1e-6f;
constexpr size_t MiB = 1u << 20;
constexpr size_t UP = (size_t)MPAD * DM * 2;
constexpr size_t UR = (size_t)MREAL * DM * 2;
constexpr size_t WS_CTL = 0, CTL_BYTES = 1 * MiB;
constexpr size_t WS_WINT = 1 * MiB;
constexpr size_t WS_W1T = 1 * MiB, WS_W2T = 9 * MiB;
constexpr size_t WS_SMALL = 20 * MiB;
constexpr size_t WS_RSTDO = 21 * MiB;
constexpr size_t WS_WAT = 23 * MiB, WS_WBT = 25 * MiB, WS_WOT = 27 * MiB;
constexpr size_t WS_R0 = 29 * MiB;
constexpr size_t WS_XA = WS_R0, WS_Q = WS_R0 + UP, WS_GF = WS_R0 + 2 * UP, WS_GB = WS_R0 + 3 * UP, WS_V = WS_R0 + 4 * UP;
constexpr size_t WS_HF = WS_Q, WS_HB = WS_GF;
constexpr size_t WS_A0B = WS_XA;
constexpr size_t WS_BRA = WS_GB, WS_BRB = WS_V;
constexpr size_t WS_SGA = WS_Q, WS_SGB = WS_GF;
constexpr size_t WS_X1 = WS_R0, WS_A1 = WS_R0 + 2 * UR, WS_HHI = WS_R0 + 3 * UR;
constexpr size_t WS_END = WS_R0 + 5 * UP;
static_assert(WS_END <= 512 * MiB, "workspace map");
constexpr int HSPLIT_PM = MREAL / 256 / 2;
constexpr size_t OUT_OB = UR;
constexpr int CW_BAR = 4096;

typedef unsigned short bf16;
typedef float f32x4 __attribute__((ext_vector_type(4)));
typedef unsigned u32x4 __attribute__((ext_vector_type(4)));
typedef unsigned u32x2 __attribute__((ext_vector_type(2)));
#define LAS __attribute__((address_space(3)))

struct Args { const float* in[21]; float* out; unsigned char* ws; int ph_lo, ph_hi, li, pad; };

__device__ __forceinline__ float bf2f(unsigned v) { return __uint_as_float(v << 16); }
__device__ __forceinline__ unsigned f2bf(float f) { unsigned u = __float_as_uint(f); return (u + 0x7fffu + ((u >> 16) & 1u)) >> 16; }
__device__ __forceinline__ unsigned pk2(float lo, float hi) { return f2bf(lo) | (f2bf(hi) << 16); }
__device__ __forceinline__ float fsigmoid(float x) { return __builtin_amdgcn_rcpf(1.f + __expf(-x)); }
__device__ __forceinline__ float wave_sum(float v) {
#pragma unroll
    for (int o = 1; o < 64; o <<= 1) v += __shfl_xor(v, o);
    return v;
}
__device__ __forceinline__ void unpack8(u32x4 w, float (&o)[8]) {
    o[0] = __uint_as_float(w.x << 16); o[1] = __uint_as_float(w.x & 0xffff0000u); o[2] = __uint_as_float(w.y << 16); o[3] = __uint_as_float(w.y & 0xffff0000u);
    o[4] = __uint_as_float(w.z << 16); o[5] = __uint_as_float(w.z & 0xffff0000u); o[6] = __uint_as_float(w.w << 16); o[7] = __uint_as_float(w.w & 0xffff0000u);
}
__device__ __forceinline__ u32x4 pack8(const float (&v)[8]) {
    u32x4 w; w.x = pg8::cvt_pk_bf16(v[0], v[1]); w.y = pg8::cvt_pk_bf16(v[2], v[3]); w.z = pg8::cvt_pk_bf16(v[4], v[5]); w.w = pg8::cvt_pk_bf16(v[6], v[7]); return w;
}
__device__ __forceinline__ const float* xrow_ptr(const Args& a, int r) { return r < NPROMPT_ROWS ? a.in[0] + (size_t)r * DM : a.in[1] + (size_t)(r - NPROMPT_ROWS) * DM; }

struct FP1 { bf16* base; const float* lb;
    __device__ __forceinline__ void operator()(int row, int col, f32x4 v0, f32x4 v1) const {
        const int cg = col >> 10, c = col & 1023;
        float v[8] = {v0[0], v0[1], v0[2], v0[3], v1[0], v1[1], v1[2], v1[3]};
        if (cg == 1) {
#pragma unroll
            for (int j = 0; j < 8; ++j) v[j] = v[j] * fsigmoid(v[j]);
        } else if (cg == 2 || cg == 3) {
            const float* l = lb + (cg - 2) * DM + c; const f32x4 l0 = *(const f32x4*)l, l1 = *(const f32x4*)(l + 4);
            const float lv[8] = {l0[0], l0[1], l0[2], l0[3], l1[0], l1[1], l1[2], l1[3]};
#pragma unroll
            for (int j = 0; j < 8; ++j) v[j] = __logf(lv[j] + (1.f - lv[j]) * fsigmoid(v[j]));
        }
        *(u32x4*)(base + (size_t)cg * (UP / 2) + (size_t)row * DM + c) = pack8(v);
    }
};
struct FP5a { const bf16* hf; const bf16* hb; const bf16* of; const bf16* ob; const float* rstdo; const float* hgg; bf16* bra; bf16* brb;
    __device__ __forceinline__ void operator()(int row, int col, f32x4 v0, f32x4 v1) const {
        const int cg = col >> 10, c = col & 1023; const size_t off = (size_t)row * DM + c;
        float v[8] = {v0[0], v0[1], v0[2], v0[3], v1[0], v1[1], v1[2], v1[3]};
        if (cg == 0) {
#ifdef EXP_V1SCAN
            float h[8], h2[8]; unpack8(*(const u32x4*)(of + (size_t)row * 2048 + c), h);
#pragma unroll
            for (int j = 0; j < 8; ++j) h2[j] = 0.f;
#else
            float h[8], h2[8]; unpack8(*(const u32x4*)(hf + off), h); unpack8(*(const u32x4*)(hb + off), h2);
#endif
#pragma unroll
            for (int j = 0; j < 8; ++j) { const float x = v[j]; v[j] = (h[j] + h2[j]) * x * fsigmoid(1.5957691216057308f * (x + 0.044715f * x * x * x)); }
            *(u32x4*)(bra + off) = pack8(v);
        } else {
#ifdef EXP_V1SCAN
            float o[8], o2[8]; unpack8(*(const u32x4*)(of + (size_t)row * 2048 + 1024 + c), o);
#pragma unroll
            for (int j = 0; j < 8; ++j) o2[j] = 0.f;
#else
            float o[8], o2[8]; unpack8(*(const u32x4*)(of + off), o); unpack8(*(const u32x4*)(ob + off), o2);
#endif
            const float rs = rstdo[(size_t)row * 8 + (c >> 7)];
            const f32x4 g0 = *(const f32x4*)(hgg + c), g1 = *(const f32x4*)(hgg + c + 4);
            const float gv[8] = {g0[0], g0[1], g0[2], g0[3], g1[0], g1[1], g1[2], g1[3]};
#pragma unroll
            for (int j = 0; j < 8; ++j) v[j] = (o[j] + o2[j]) * rs * gv[j] * (v[j] * fsigmoid(v[j]));
            *(u32x4*)(brb + off) = pack8(v);
        }
    }
};
struct FP5b { bf16* sga; bf16* sgb; const float* dmy;
    __device__ __forceinline__ void operator()(int row, int col, f32x4 v0, f32x4 v1) const {
        const int cg = col >> 10, c = col & 1023;
        float v[8] = {v0[0], v0[1], v0[2], v0[3], v1[0], v1[1], v1[2], v1[3]};
#ifdef EXP_SLEEP
        __builtin_amdgcn_s_sleep(127);
#endif
#ifdef EXP_DLOAD
        const f32x4 dz = *(const f32x4*)(dmy + c);
#pragma unroll
        for (int j = 0; j < 8; ++j) v[j] = fsigmoid(v[j]) + 0.f * dz[j & 3];
#else
#pragma unroll
        for (int j = 0; j < 8; ++j) v[j] = fsigmoid(v[j]);
#endif
        *(u32x4*)((cg == 0 ? sga : sgb) + (size_t)row * DM + c) = pack8(v);
    }
};
struct FP3b1 { const bf16* sg; bf16* t1;
    __device__ __forceinline__ void operator()(int row, int col, f32x4 v0, f32x4 v1) const {
        float v[8] = {v0[0], v0[1], v0[2], v0[3], v1[0], v1[1], v1[2], v1[3]}; float s[8]; unpack8(*(const u32x4*)(sg + (size_t)row * DM + col), s);
#pragma unroll
        for (int j = 0; j < 8; ++j) v[j] *= s[j];
        *(u32x4*)(t1 + (size_t)row * DM + col) = pack8(v);
    }
};
struct FP3b2 { const bf16* sg; bf16* t1;
    __device__ __forceinline__ void operator()(int row, int col, f32x4 v0, f32x4 v1) const {
        float v[8] = {v0[0], v0[1], v0[2], v0[3], v1[0], v1[1], v1[2], v1[3]}; float s[8], t[8];
        unpack8(*(const u32x4*)(sg + (size_t)row * DM + col), s); unpack8(*(const u32x4*)(t1 + (size_t)row * DM + col), t);
#pragma unroll
        for (int j = 0; j < 8; ++j) v[j] = t[j] + v[j] * s[j];
        *(u32x4*)(t1 + (size_t)row * DM + col) = pack8(v);
    }
};
struct FP3c { const float* xp; const float* xs; float* x1;
    __device__ __forceinline__ void operator()(int row, int col, f32x4 v0, f32x4 v1) const {
        const float* xr = (row < NPROMPT_ROWS ? xp + (size_t)row * DM : xs + (size_t)(row - NPROMPT_ROWS) * DM) + col;
        float* o = x1 + (size_t)row * DM + col;
        *(f32x4*)o = *(const f32x4*)xr + v0; *(f32x4*)(o + 4) = *(const f32x4*)(xr + 4) + v1;
    }
};
struct FP4 { bf16* hlo; bf16* hhi;
    __device__ __forceinline__ void operator()(int row, int col, f32x4 v0, f32x4 v1) const {
        float v[8] = {v0[0], v0[1], v0[2], v0[3], v1[0], v1[1], v1[2], v1[3]};
#pragma unroll
        for (int j = 0; j < 8; ++j) { const float r = fmaxf(v[j], 0.f); v[j] = r * r; }
        bf16* o = row < HSPLIT_PM * 256 ? hlo + (size_t)row * DFF : hhi + (size_t)(row - HSPLIT_PM * 256) * DFF;
        *(u32x4*)(o + col) = pack8(v);
    }
};
struct FP5 { float* x1;
    __device__ __forceinline__ void operator()(int row, int col, f32x4 v0, f32x4 v1) const {
        float* o = x1 + (size_t)row * DM + col;
        *(f32x4*)o = *(const f32x4*)o + v0; *(f32x4*)(o + 4) = *(const f32x4*)(o + 4) + v1;
    }
};

#define XB_TMO      128
#define XB_XCNT(j)  (256  + 64 * (j))
#define XB_XSUB(j)  (1280 + 64 * (j))
#define XB_XGEN(j)  (2304 + 64 * (j))
#define XB_TOP      3328
#define XB_TOPGEN   3392
#define XCD_BAR_WORDS 3456
#define XB_SPIN_CAP (1u << 22)

__device__ __forceinline__ unsigned xb_ld(unsigned* p)              { return __hip_atomic_load(p, __ATOMIC_RELAXED, __HIP_MEMORY_SCOPE_AGENT); }
__device__ __forceinline__ unsigned xb_add(unsigned* p, unsigned v) { return __hip_atomic_fetch_add(p, v, __ATOMIC_RELAXED, __HIP_MEMORY_SCOPE_AGENT); }
__device__ __forceinline__ unsigned xb_xcc_id() { return (unsigned)__builtin_amdgcn_s_getreg((3 << 11) | 20) & 0xFu; }
#define XB_SPIN(cond, bar) do { unsigned _sp = 0; while (cond) { __builtin_amdgcn_s_sleep(1); \
    if ((++_sp & 255u) == 0u) { if (xb_ld(&(bar)[XB_TMO])) break; if (_sp > XB_SPIN_CAP) { atomicAdd(&(bar)[XB_TMO], 1u); break; } } } } while (0)

struct XcdBarrier {
    unsigned* bar; unsigned x;
    volatile LAS unsigned* st;
};

__device__ __forceinline__ XcdBarrier xcd_barrier_post(unsigned* bar, volatile LAS unsigned* st) {
    XcdBarrier b; b.bar = bar; b.x = xb_xcc_id(); b.st = st;
    if (threadIdx.x == 0) (void)xb_add(&bar[XB_XCNT(b.x)], 1u);
    return b;
}
__device__ __forceinline__ void xcd_barrier_complete(unsigned* bar, unsigned x, unsigned& nloc, unsigned& nx) {
    const unsigned G = gridDim.x * gridDim.y * gridDim.z;
    unsigned sum, cnt, mine, sp = 0u;
    for (;;) {
        sum = 0u; cnt = 0u; mine = 0u;
#pragma unroll
        for (unsigned j = 0; j < 16; ++j) { const unsigned c = xb_ld(&bar[XB_XCNT(j)]); sum += c; cnt += (c > 0u) ? 1u : 0u; mine = (j == x) ? c : mine; }
        if (sum == G) break;
        __builtin_amdgcn_s_sleep(1);
        if ((++sp & 255u) == 0u) { if (xb_ld(&bar[XB_TMO])) break; if (sp > XB_SPIN_CAP) { atomicAdd(&bar[XB_TMO], 1u); break; } }
    }
    nloc = mine > 0u ? mine : 1u; nx = cnt > 0u ? cnt : 1u;
}

__device__ __forceinline__ void xcd_barrier(const XcdBarrier& b) {
    asm volatile("s_waitcnt vmcnt(0)" ::: "memory");
    __syncthreads();
    if (threadIdx.x == 0) {
        unsigned* bar = b.bar;
        __builtin_amdgcn_s_waitcnt(0);
        unsigned nloc = b.st[0], nx = b.st[1];
        if (nloc == 0u) { xcd_barrier_complete(bar, b.x, nloc, nx); b.st[0] = nloc; b.st[1] = nx; }
        const unsigned old = xb_add(&bar[XB_XSUB(b.x)], 1u);
        const unsigned gen = old / nloc;
        if (old + 1u == (gen + 1u) * nloc) {
            __builtin_amdgcn_fence(__ATOMIC_RELEASE, "agent");
            asm volatile("s_waitcnt vmcnt(0)" ::: "memory");
            const unsigned og = xb_add(&bar[XB_TOP], 1u);
            const unsigned tg = og / nx;
            if (og + 1u == (tg + 1u) * nx) xb_add(&bar[XB_TOPGEN], 1u);
            else XB_SPIN(xb_ld(&bar[XB_TOPGEN]) == tg, bar);
            __builtin_amdgcn_fence(__ATOMIC_ACQUIRE, "agent");
            xb_add(&bar[XB_XGEN(b.x)], 1u);
            asm volatile("s_waitcnt vmcnt(0)" ::: "memory");
        } else {
            XB_SPIN(xb_ld(&bar[XB_XGEN(b.x)]) == gen, bar);
            __builtin_amdgcn_fence(__ATOMIC_ACQUIRE, "agent");
            asm volatile("s_waitcnt vmcnt(0)" ::: "memory");
        }
    }
    __syncthreads();
}

__device__ __forceinline__ void transpose_item(const float* W, int K, int N, bf16* WT, int k0, int n0, int dst_row0, float* scr, int lane) {
#pragma unroll 8
    for (int i = 0; i < 32; ++i) { const int kk = 2 * i + (lane >> 5); scr[kk * 33 + (lane & 31)] = W[(size_t)(k0 + kk) * N + n0 + (lane & 31)]; }
    asm volatile("s_waitcnt lgkmcnt(0)" ::: "memory");
    const int c = lane & 7;
#pragma unroll
    for (int j = 0; j < 4; ++j) { const int n = (lane >> 3) + 8 * j; const float* s = scr + (8 * c) * 33 + n;
        u32x4 o; o.x = pk2(s[0 * 33], s[1 * 33]); o.y = pk2(s[2 * 33], s[3 * 33]); o.z = pk2(s[4 * 33], s[5 * 33]); o.w = pk2(s[6 * 33], s[7 * 33]);
        *(u32x4*)(WT + (size_t)(dst_row0 + n) * K + k0 + 8 * c) = o; }
    asm volatile("s_waitcnt lgkmcnt(0)" ::: "memory");
}
__device__ __forceinline__ void norm_row_bf16(const float* xrow, const float* gain, bf16* orow, int lane) {
    const f32x4* xr = (const f32x4*)xrow + lane; f32x4 v[4]; float s = 0.f;
#pragma unroll
    for (int j = 0; j < 4; ++j) { v[j] = xr[64 * j]; s += (v[j].x * v[j].x + v[j].y * v[j].y) + (v[j].z * v[j].z + v[j].w * v[j].w); }
    const float rstd = rsqrtf(wave_sum(s) * (1.f / DM) + EPS);
    u32x2* o8 = (u32x2*)orow + lane;
#pragma unroll
    for (int j = 0; j < 4; ++j) { const f32x4 g = ((const f32x4*)gain)[lane + 64 * j]; u32x2 w; w.x = pk2(v[j].x * rstd * g.x, v[j].y * rstd * g.y); w.y = pk2(v[j].z * rstd * g.z, v[j].w * rstd * g.w); o8[64 * j] = w; }
}
__device__ __forceinline__ int win_dst_group(int g) { return g == 0 ? 0 : g == 1 ? 5 : g <= 5 ? g - 1 : g; }

__device__ __forceinline__ void phase_prep0(const Args& a, float* scr, int gw, int NGW, int gtid, int lane) {
    unsigned char* ws = a.ws;
    { float* sm = (float*)(ws + WS_SMALL);
      if (gtid < 2048) { const float l0 = a.in[3][gtid], l1 = a.in[3][2048 + gtid]; const float m = fmaxf(l0, l1); const float e0 = expf(l0 - m), e1 = expf(l1 - m); sm[gtid] = e0 / (e0 + e1); }
      else if (gtid < 4096) { const float lam = a.in[12][gtid - 2048]; sm[gtid] = -8.f * log1pf(expf(-lam)); } }
    constexpr int I_WIN = (DM / 64) * (NIN / 32), I_SQ = (DM / 64) * (DM / 32);
    for (int it = gw; it < I_WIN + 3 * I_SQ; it += NGW) {
        int r = it;
        if (r < I_WIN) { const int nblk = NIN / 32, kb = r / nblk, nb = r % nblk, n0 = nb * 32; transpose_item(a.in[5], DM, NIN, (bf16*)(ws + WS_WINT), kb * 64, n0, win_dst_group(n0 >> 10) * 1024 + (n0 & 1023), scr, lane); continue; }
        r -= I_WIN; const int which = r / I_SQ; r %= I_SQ; const int nblk = DM / 32, kb = r / nblk, nb = r % nblk;
        transpose_item(a.in[14 + which], DM, DM, (bf16*)(ws + (which == 0 ? WS_WAT : which == 1 ? WS_WBT : WS_WOT)), kb * 64, nb * 32, nb * 32, scr, lane);
    }
    bf16* A0 = (bf16*)a.out;
    for (int m = gw; m < MPAD; m += NGW) {
        if (m < MREAL) norm_row_bf16(xrow_ptr(a, m), a.in[4], A0 + (size_t)m * DM, lane);
        else if (m < MREAL + NMETA) norm_row_bf16(a.in[2] + (size_t)(m - MREAL) * DM, a.in[4], A0 + (size_t)m * DM, lane);
        else { u32x4* o = (u32x4*)(A0 + (size_t)m * DM); o[lane] = (u32x4){0u, 0u, 0u, 0u}; o[lane + 64] = (u32x4){0u, 0u, 0u, 0u}; }
    }
}
__device__ __forceinline__ void phase_prep2(const Args& a, int gw, int NGW, int lane) {
    unsigned char* ws = a.ws; bf16* A0 = (bf16*)(ws + WS_A0B); const bf16* of = (const bf16*)a.out; const bf16* ob = (const bf16*)((const unsigned char*)a.out + OUT_OB); float* rstdo = (float*)(ws + WS_RSTDO);
    for (int m = gw; m < MREAL; m += NGW) {
        norm_row_bf16(xrow_ptr(a, m), a.in[4], A0 + (size_t)m * DM, lane);
#ifdef EXP_V1SCAN
        const u32x4* op = (const u32x4*)(of + (size_t)m * 2048 + 1024) + 2 * lane;
        float o[8], p[8], o2[8], p2[8]; unpack8(op[0], o); unpack8(op[1], p); float ss = 0.f;
#pragma unroll
        for (int j = 0; j < 8; ++j) { o2[j] = 0.f; p2[j] = 0.f; }
#else
        const u32x4* op = (const u32x4*)(of + (size_t)m * DM) + 2 * lane; const u32x4* oq = (const u32x4*)(ob + (size_t)m * DM) + 2 * lane;
        float o[8], p[8], o2[8], p2[8]; unpack8(op[0], o); unpack8(op[1], p); unpack8(oq[0], o2); unpack8(oq[1], p2); float ss = 0.f;
#endif
#pragma unroll
        for (int j = 0; j < 8; ++j) { const float x = o[j] + o2[j], y = p[j] + p2[j]; ss += x * x + y * y; }
        ss += __shfl_xor(ss, 1); ss += __shfl_xor(ss, 2); ss += __shfl_xor(ss, 4);
        if ((lane & 7) == 0) rstdo[(size_t)m * 8 + (lane >> 3)] = rsqrtf(ss * (1.f / 128.f) + EPS);
    }
}
__device__ __forceinline__ void phase_prep3(const Args& a, float* scr, int gw, int NGW, int lane) {
    unsigned char* ws = a.ws;
    constexpr int I_1 = (DM / 64) * (DFF / 32), I_2 = (DFF / 64) * (DM / 32);
    for (int it = gw; it < I_1 + I_2; it += NGW) {
        if (it < I_1) { const int nblk = DFF / 32, kb = it / nblk, nb = it % nblk; transpose_item(a.in[18], DM, DFF, (bf16*)(ws + WS_W1T), kb * 64, nb * 32, nb * 32, scr, lane); }
        else { const int r = it - I_1, nblk = DM / 32, kb = r / nblk, nb = r % nblk; transpose_item(a.in[19], DFF, DM, (bf16*)(ws + WS_W2T), kb * 64, nb * 32, nb * 32, scr, lane); }
    }
}
__device__ __forceinline__ void phase_norm1(const Args& a, int gw, int NGW, int lane) {
    unsigned char* ws = a.ws;
    for (int m = gw; m < MREAL; m += NGW) norm_row_bf16((const float*)(ws + WS_X1) + (size_t)m * DM, a.in[17], (bf16*)(ws + WS_A1) + (size_t)m * DM, lane);
}
__device__ __forceinline__ void phase_final(const Args& a, int gw, int NGW, int lane) {
    unsigned char* ws = a.ws;
    for (int m = gw; m < MREAL; m += NGW) {
        const f32x4* xr = (const f32x4*)((const float*)(ws + WS_X1) + (size_t)m * DM) + lane; f32x4 v[4]; float s = 0.f;
#pragma unroll
        for (int j = 0; j < 4; ++j) { v[j] = xr[64 * j]; s += (v[j].x * v[j].x + v[j].y * v[j].y) + (v[j].z * v[j].z + v[j].w * v[j].w); }
        const float rstd = rsqrtf(wave_sum(s) * (1.f / DM) + EPS);
        f32x4* o = (f32x4*)(a.out + (size_t)m * DM) + lane;
#pragma unroll
        for (int j = 0; j < 4; ++j) { const f32x4 g = ((const f32x4*)a.in[20])[lane + 64 * j]; o[64 * j] = v[j] * rstd * g; }
    }
}

__device__ __forceinline__ size_t in_row(int s, int p) { return p < NMETA ? (size_t)(MREAL + p) : (size_t)s * SEQ + (p - NMETA); }
__device__ __forceinline__ float xa_at(const bf16* XA, int s, int p, int C) { return (p < 0 || p >= LTOT) ? 0.f : bf2f(XA[in_row(s, p) * DM + C]); }

template <int DIR> __device__ __forceinline__ void rglru_sweep(const Args& a, float* Was, float* Wxs, float* xcs, int s, int h, int c) {
    const int C = h * 128 + c; unsigned char* ws = a.ws; const bf16* XA = (const bf16*)(ws + WS_XA); bf16* hout = (bf16*)(ws + (DIR == 0 ? WS_HF : WS_HB));
    const float cw0 = a.in[6][C], cw1 = a.in[6][DM + C], cw2 = a.in[6][2 * DM + C], cw3 = a.in[6][3 * DM + C], cb = a.in[7][C];
    for (int i = c; i < 128 * 128; i += 128) { Was[i] = a.in[8][(size_t)(DIR * 8 + h) * 16384 + i]; Wxs[i] = a.in[10][(size_t)(DIR * 8 + h) * 16384 + i]; }
    const float ba = a.in[9][DIR * DM + C], bx = a.in[11][DIR * DM + C], cl = ((const float*)(ws + WS_SMALL))[2048 + DIR * DM + C];
    float hst = 0.f;
    const int ntile = DIR == 0 ? LTOT / 16 : SEQ / 16;
    for (int tl = 0; tl < ntile; ++tl) {
        const int p0 = DIR == 0 ? tl * 16 : LTOT - 16 * (tl + 1);
        float xv[19];
#pragma unroll
        for (int j = 0; j < 19; ++j) xv[j] = xa_at(XA, s, p0 - 2 + j, C);
        float xc[16];
#pragma unroll
        for (int t = 0; t < 16; ++t) xc[t] = cb + cw0 * xv[t] + cw1 * xv[t + 1] + cw2 * xv[t + 2] + cw3 * xv[t + 3];
        __syncthreads();
#pragma unroll
        for (int t = 0; t < 16; ++t) xcs[t * 128 + c] = xc[t];
        __syncthreads();
        float ra[16], rx[16];
#pragma unroll
        for (int t = 0; t < 16; ++t) { ra[t] = ba; rx[t] = bx; }
        for (int i = 0; i < 128; ++i) { const float wa = Was[i * 128 + c], wx = Wxs[i * 128 + c];
#pragma unroll
            for (int t = 0; t < 16; ++t) { const float xi = xcs[t * 128 + i]; ra[t] += xi * wa; rx[t] += xi * wx; } }
#pragma unroll
        for (int k = 0; k < 16; ++k) { const int t = DIR == 0 ? k : 15 - k;
            const float r = 1.f / (1.f + expf(-ra[t])), ig = 1.f / (1.f + expf(-rx[t])); const float la = cl * r; const float av = expf(la), mult = sqrtf(-expm1f(2.f * la));
            hst = av * hst + mult * (ig * xc[t]);
            const int p = p0 + t;
#ifdef EXP_V1SCAN
            if (p >= NMETA) { bf16* dst = (bf16*)a.out + ((size_t)s * SEQ + (p - NMETA)) * 2048 + C; if (DIR == 1) *dst = (bf16)f2bf(hst); else *dst = (bf16)f2bf(bf2f(*dst) + hst); } }
#else
            if (p >= NMETA) hout[((size_t)s * SEQ + (p - NMETA)) * DM + C] = (bf16)f2bf(hst); }
#endif
    }
}
__global__ void __launch_bounds__(128) k_rglru_naive(Args a) {
    extern __shared__ __attribute__((aligned(16))) unsigned char lds[];
    float* Was = (float*)lds; float* Wxs = Was + 16384; float* xcs = Wxs + 16384;
#ifdef EXP_A
    const int s = blockIdx.x / 8, h = blockIdx.x % 8, c = threadIdx.x;
    rglru_sweep<1>(a, Was, Wxs, xcs, s, h, c); __syncthreads(); rglru_sweep<0>(a, Was, Wxs, xcs, s, h, c);
#else
    const int dir = blockIdx.x / 48, s = (blockIdx.x % 48) / 8, h = blockIdx.x % 8, c = threadIdx.x;
    if (dir == 0) rglru_sweep<0>(a, Was, Wxs, xcs, s, h, c); else rglru_sweep<1>(a, Was, Wxs, xcs, s, h, c);
#endif
}

template <int DIR> __device__ __forceinline__ void hgrn_sweep(const Args& a, float (*qs)[128], float (*fs)[128], float (*ks)[128], int s, int hd, int j) {
    const int C = hd * 128 + j; unsigned char* ws = a.ws; bf16* oout = (bf16*)((unsigned char*)a.out + (DIR == 0 ? 0 : OUT_OB));
    const bf16* Q = (const bf16*)(ws + WS_Q); const bf16* G = (const bf16*)(ws + (DIR == 0 ? WS_GF : WS_GB)); const bf16* V = (const bf16*)(ws + WS_V);
    float S[128];
#pragma unroll
    for (int k = 0; k < 128; ++k) S[k] = 0.f;
    const int nsteps = DIR == 0 ? LTOT : SEQ;
    size_t r0 = in_row(s, DIR == 0 ? 0 : LTOT - 1);
    float nq = bf2f(Q[r0 * DM + C]), ng = bf2f(G[r0 * DM + C]), nv = bf2f(V[r0 * DM + C]);
    for (int st = 0; st < nsteps; ++st) {
        const int p = DIR == 0 ? st : LTOT - 1 - st; const int buf = st & 1;
        const float qv = nq, gv = ng, vv = nv;
        if (st + 1 < nsteps) { const size_t rn = in_row(s, DIR == 0 ? p + 1 : p - 1); nq = bf2f(Q[rn * DM + C]); ng = bf2f(G[rn * DM + C]); nv = bf2f(V[rn * DM + C]); }
        qs[buf][j] = qv; fs[buf][j] = expf(gv); ks[buf][j] = -expm1f(gv);
        __syncthreads();
        float o = 0.f;
#pragma unroll
        for (int k = 0; k < 128; ++k) { S[k] = fs[buf][k] * S[k] + ks[buf][k] * vv; o += qs[buf][k] * S[k]; }
#ifdef EXP_V1SCAN
        if (p >= NMETA) { bf16* dst = (bf16*)a.out + ((size_t)s * SEQ + (p - NMETA)) * 2048 + 1024 + C; if (DIR == 1) *dst = (bf16)f2bf(o); else *dst = (bf16)f2bf(bf2f(*dst) + o); }
#else
        if (p >= NMETA) oout[((size_t)s * SEQ + (p - NMETA)) * DM + C] = (bf16)f2bf(o);
#endif
    }
}
__global__ void __launch_bounds__(128) k_hgrn_naive(Args a) {
    __shared__ float qs[2][128], fs[2][128], ks[2][128];
#ifdef EXP_A
    const int s = blockIdx.x / 8, hd = blockIdx.x % 8, j = threadIdx.x;
    hgrn_sweep<1>(a, qs, fs, ks, s, hd, j); __syncthreads(); hgrn_sweep<0>(a, qs, fs, ks, s, hd, j);
#else
    const int dir = blockIdx.x / 48, s = (blockIdx.x % 48) / 8, hd = blockIdx.x % 8, j = threadIdx.x;
    if (dir == 0) hgrn_sweep<0>(a, qs, fs, ks, s, hd, j); else hgrn_sweep<1>(a, qs, fs, ks, s, hd, j);
#endif
}

constexpr int LDS_RING = 131072, LDSCTL_OFF = LDS_RING, LDS_BYTES = 147456;
template <int ONLY> __global__ void __launch_bounds__(512, 2) mega_t(Args a) {
    extern __shared__ __attribute__((aligned(16))) unsigned char lds[];
    PG8_LAS unsigned char* L = (PG8_LAS unsigned char*)lds;
    const int tid = threadIdx.x, lane = tid & 63, wave = __builtin_amdgcn_readfirstlane(tid >> 6);
    const int G = gridDim.x, gw = blockIdx.x * 8 + wave, NGW = G * 8, gtid = blockIdx.x * 512 + tid;
    unsigned char* ws = a.ws; bf16* outb = (bf16*)a.out;
#ifdef EXP_NOPROLOG
    XcdBarrier bar; bar.bar = (unsigned*)(ws + WS_CTL) + CW_BAR; bar.x = 0; bar.st = (volatile LAS unsigned*)(L + LDSCTL_OFF + 64);
#else
    for (int u = tid; u < (LDS_BYTES - LDSCTL_OFF) / 4; u += 512) ((LAS unsigned*)(L + LDSCTL_OFF))[u] = 0u;
    __syncthreads();
    XcdBarrier bar = xcd_barrier_post((unsigned*)(ws + WS_CTL) + CW_BAR + a.li * XCD_BAR_WORDS, (volatile LAS unsigned*)(L + LDSCTL_OFF + 64));
#endif
    const int lo = a.ph_lo, hi = a.ph_hi;
#define IN(k) (ONLY < 0 ? (lo <= (k) && (k) < hi) : (ONLY == (k)))
#define SEAM(k) do { if (ONLY < 0 && (k) + 1 < hi) xcd_barrier(bar); } while (0)
    float* scr = (float*)(lds + wave * 8448);
    constexpr int NOSPLIT = 1 << 30;
    pg8::StaticOrder S;
    if (IN(0)) { phase_prep0(a, scr, gw, NGW, gtid, lane); SEAM(0); }
    if (IN(1)) {
        pg8::Gemm g{outb, (const bf16*)(ws + WS_WINT), MPAD, NIN1, DM, outb, NOSPLIT}; S.init(MPAD, NIN1, G, blockIdx.x);
        pg8::EpiRow8<FP1> E{{(bf16*)(ws + WS_XA), (const float*)(ws + WS_SMALL)}};
        pg8::gemm_phase<pg8::EpiRow8<FP1>, pg8::StaticOrder, true, true>(L, g, S, E); SEAM(1);
    }
    if (IN(4)) { phase_prep2(a, gw, NGW, lane); SEAM(4); }
    if (IN(5)) {
        pg8::Gemm g{(const bf16*)(ws + WS_A0B), (const bf16*)(ws + WS_WINT) + (size_t)NIN1 * DM, MREAL, 2048, DM, (const bf16*)(ws + WS_A0B), NOSPLIT}; S.init(MREAL, 2048, G, blockIdx.x);
        pg8::EpiRow8<FP5a> E{{(const bf16*)(ws + WS_HF), (const bf16*)(ws + WS_HB), outb, (const bf16*)((unsigned char*)a.out + OUT_OB), (const float*)(ws + WS_RSTDO), a.in[13], (bf16*)(ws + WS_BRA), (bf16*)(ws + WS_BRB)}};
        pg8::gemm_phase<pg8::EpiRow8<FP5a>, pg8::StaticOrder, true, true>(L, g, S, E); SEAM(5);
    }
    if (IN(6)) {
        pg8::Gemm g{(const bf16*)(ws + WS_A0B), (const bf16*)(ws + WS_WINT) + (size_t)(NIN1 + 2048) * DM, MREAL, 2048, DM, (const bf16*)(ws + WS_A0B), NOSPLIT}; S.init(MREAL, 2048, G, blockIdx.x);
        pg8::EpiRow8<FP5b> E{{(bf16*)(ws + WS_SGA), (bf16*)(ws + WS_SGB), a.in[13]}};
        pg8::gemm_phase<pg8::EpiRow8<FP5b>, pg8::StaticOrder, true, true>(L, g, S, E); SEAM(6);
    }
    if (IN(7)) {
        pg8::Gemm g{(const bf16*)(ws + WS_BRA), (const bf16*)(ws + WS_WAT), MREAL, DM, DM, (const bf16*)(ws + WS_BRA), NOSPLIT}; S.init(MREAL, DM, G, blockIdx.x);
        pg8::EpiRow8<FP3b1> E{{(const bf16*)(ws + WS_SGA), outb}};
        pg8::gemm_phase<pg8::EpiRow8<FP3b1>, pg8::StaticOrder, true, true>(L, g, S, E);
#ifndef EXP_X2
        __syncthreads(); phase_prep3(a, scr, gw, NGW, lane);
#endif
        SEAM(7);
    }
    if (IN(8)) {
        pg8::Gemm g{(const bf16*)(ws + WS_BRB), (const bf16*)(ws + WS_WBT), MREAL, DM, DM, (const bf16*)(ws + WS_BRB), NOSPLIT}; S.init(MREAL, DM, G, blockIdx.x);
        pg8::EpiRow8<FP3b2> E{{(const bf16*)(ws + WS_SGB), outb}};
        pg8::gemm_phase<pg8::EpiRow8<FP3b2>, pg8::StaticOrder, true, true>(L, g, S, E); SEAM(8);
    }
    if (IN(9)) {
        pg8::Gemm g{outb, (const bf16*)(ws + WS_WOT), MREAL, DM, DM, outb, NOSPLIT}; S.init(MREAL, DM, G, blockIdx.x);
        pg8::EpiRow8<FP3c> E{{a.in[0], a.in[1], (float*)(ws + WS_X1)}};
        pg8::gemm_phase<pg8::EpiRow8<FP3c>, pg8::StaticOrder, true, true>(L, g, S, E); SEAM(9);
    }
    if (IN(10)) { phase_norm1(a, gw, NGW, lane); SEAM(10); }
    if (IN(11)) {
        pg8::Gemm g{(const bf16*)(ws + WS_A1), (const bf16*)(ws + WS_W1T), MREAL, DFF, DM, (const bf16*)(ws + WS_A1), NOSPLIT}; S.init(MREAL, DFF, G, blockIdx.x);
        pg8::EpiRow8<FP4> E{{outb, (bf16*)(ws + WS_HHI)}};
        pg8::gemm_phase<pg8::EpiRow8<FP4>, pg8::StaticOrder, true, true>(L, g, S, E); SEAM(11);
    }
    if (IN(12)) {
        pg8::Gemm g{outb, (const bf16*)(ws + WS_W2T), MREAL, DM, DFF, (const bf16*)(ws + WS_HHI), HSPLIT_PM}; S.init(MREAL, DM, G, blockIdx.x);
        pg8::EpiRow8<FP5> E{{(float*)(ws + WS_X1)}};
        pg8::gemm_phase<pg8::EpiRow8<FP5>, pg8::StaticOrder, true, true>(L, g, S, E); SEAM(12);
    }
    if (IN(13)) { phase_final(a, gw, NGW, lane); }
#ifdef EXP_X2
    if (ONLY == 14) { phase_prep3(a, scr, gw, NGW, lane); }
#endif
#undef IN
#undef SEAM
}


#ifdef EXP_CKSUM
constexpr size_t WS_DIAG = 22 * MiB + 512 * 1024;
__global__ void __launch_bounds__(256) k_cksum(const unsigned* p, size_t nwords, unsigned long long* slot) {
    unsigned long long acc = 0;
    for (size_t i = (size_t)blockIdx.x * 256 + threadIdx.x; i < nwords; i += (size_t)gridDim.x * 256) { const unsigned w = p[i]; acc += (unsigned long long)w * (unsigned long long)((i & 1023) * 2 + 1); }
    for (int o = 1; o < 64; o <<= 1) acc += __shfl_xor(acc, o);
    if ((threadIdx.x & 63) == 0) atomicAdd(slot, acc);
}
__global__ void k_ckinit(unsigned long long* d) { if (threadIdx.x == 0 && blockIdx.x == 0 && d[64] != 0x1234567855aa33ccull) { for (int k = 0; k < 66; ++k) d[k] = 0; } }
__global__ void k_cmp(unsigned long long* d) {
    if (threadIdx.x || blockIdx.x) return;
    const unsigned long long MAGIC = 0x1234567855aa33ccull;
    if (d[64] == MAGIC) { if (d[65] == 0) { for (int k = 1; k < 32; ++k) if (d[k] != d[32 + k]) { d[65] = (unsigned long long)k; break; } } }
    else { d[65] = 0; }
    for (int k = 0; k < 32; ++k) { d[32 + k] = d[k]; d[k] = 0; }
    d[64] = MAGIC;
}
__global__ void __launch_bounds__(256) k_scale(float* y, size_t n, const unsigned long long* d) {
    const float sc = 1.f + 0.1f * (float)d[65];
    if (d[65] == 0) return;
    for (size_t i = (size_t)blockIdx.x * 256 + threadIdx.x; i < n; i += (size_t)gridDim.x * 256) y[i] *= sc;
}
#define CK(k, ptr, bytes) hipLaunchKernelGGL(k_cksum, dim3(1024), dim3(256), 0, stream, (const unsigned*)(ptr), (size_t)(bytes) / 4, (unsigned long long*)((char*)d_ws + WS_DIAG) + (k))
#else
#define CK(k, ptr, bytes) do {} while (0)
#endif
#ifdef EXP_FLUSH
__global__ void __launch_bounds__(256) k_flush(Args a) {
    const size_t n = (size_t)MREAL * DM / 4; const f32x4* p0 = (const f32x4*)a.in[0]; const f32x4* p1 = (const f32x4*)a.in[1];
    f32x4 acc = {0.f, 0.f, 0.f, 0.f};
    for (size_t i = (size_t)blockIdx.x * 256 + threadIdx.x; i < n; i += (size_t)gridDim.x * 256) { const f32x4 v = i < (size_t)NPROMPT_ROWS * DM / 4 ? p0[i] : p1[i - (size_t)NPROMPT_ROWS * DM / 4]; acc += v; }
    if (acc.x + acc.y + acc.z + acc.w == 1.2345e30f) ((float*)(a.ws + WS_SMALL))[8191] = 1.f;
}
#define FLUSH() hipLaunchKernelGGL(k_flush, dim3(2048), dim3(256), 0, stream, a)
#else
#define FLUSH() do {} while (0)
#endif
#ifdef EXP_A
#define NAIVE_WGS 48
#else
#define NAIVE_WGS 96
#endif
#define mega mega_t<-1>
extern "C" void kernel_launch(void* const* d_in, const int* in_sizes, int n_in, void* d_out, int out_size, void* d_ws, size_t ws_size, hipStream_t stream) {
    static int grid = 0;
    constexpr int RG_LDS = (2 * 16384 + 16 * 128) * 4;
    if (grid == 0) {
        if (n_in != 21 || out_size != MREAL * DM || ws_size < WS_END) { fprintf(stderr, "kernel_launch: unexpected shapes (n_in %d, out %d, ws %zu)\n", n_in, out_size, ws_size); grid = -1; return; }
        int dev = 0, cus = 0, per_cu = 0;
        if (hipGetDevice(&dev) != hipSuccess || hipDeviceGetAttribute(&cus, hipDeviceAttributeMultiprocessorCount, dev) != hipSuccess) { grid = -1; return; }
        #ifdef EXP_TEMPL
#define SA(k) (void)hipFuncSetAttribute((const void*)mega_t<k>, hipFuncAttributeMaxDynamicSharedMemorySize, LDS_BYTES);
        SA(14) SA(0) SA(1) SA(4) SA(5) SA(6) SA(7) SA(8) SA(9) SA(10) SA(11) SA(12) SA(13)
#undef SA
#endif
        if (hipFuncSetAttribute((const void*)mega, hipFuncAttributeMaxDynamicSharedMemorySize, LDS_BYTES) != hipSuccess || hipFuncSetAttribute((const void*)k_rglru_naive, hipFuncAttributeMaxDynamicSharedMemorySize, RG_LDS) != hipSuccess) { fprintf(stderr, "kernel_launch: hipFuncSetAttribute failed\n"); grid = -1; return; }
        if (hipOccupancyMaxActiveBlocksPerMultiprocessor(&per_cu, (const void*)mega, 512, LDS_BYTES) != hipSuccess || per_cu < 1) { fprintf(stderr, "kernel_launch: occupancy query says %d workgroups per CU\n", per_cu); (void)hipGetLastError(); grid = -1; return; }
        grid = cus;
    }
    if (grid < 0) return;
#ifdef DIAG_POISON
    (void)hipMemsetAsync((char*)d_ws, 0xAA, WS_END, stream); (void)hipMemsetAsync((char*)d_out, 0xAA, (size_t)MREAL * DM * 4, stream);
#endif
    (void)hipMemsetAsync((char*)d_ws + WS_CTL, 0, CTL_BYTES, stream);
    Args a{};
    for (int i = 0; i < 21; ++i) a.in[i] = (const float*)d_in[i];
    a.out = (float*)d_out; a.ws = (unsigned char*)d_ws;
#ifndef ONE_PER_PHASE
    a.ph_lo = 0; a.ph_hi = 2; a.li = 0;
    hipLaunchKernelGGL(mega, dim3(grid), dim3(512), LDS_BYTES, stream, a);
    hipLaunchKernelGGL(k_hgrn_naive, dim3(NAIVE_WGS), dim3(128), 0, stream, a);
    hipLaunchKernelGGL(k_rglru_naive, dim3(NAIVE_WGS), dim3(128), RG_LDS, stream, a);
    a.ph_lo = 4; a.ph_hi = 14; a.li = 1;
    hipLaunchKernelGGL(mega, dim3(grid), dim3(512), LDS_BYTES, stream, a);
#else
#ifdef EXP_CKSUM
    hipLaunchKernelGGL(k_ckinit, dim3(1), dim3(64), 0, stream, (unsigned long long*)((char*)d_ws + WS_DIAG));
#endif
#ifdef EXP_TWICE
    for (int rep = 0; rep < 2; ++rep)
#endif
    for (int ph = 0; ph < 14; ++ph) {
#ifdef EXP_X2
        if (ph == 3) { hipLaunchKernelGGL(k_hgrn_naive, dim3(NAIVE_WGS), dim3(128), 0, stream, a); FLUSH(); continue; }
        if (ph == 2) { hipLaunchKernelGGL(k_rglru_naive, dim3(NAIVE_WGS), dim3(128), RG_LDS, stream, a); FLUSH(); continue; }
        if (ph == 7) { hipLaunchKernelGGL(mega_t<14>, dim3(grid), dim3(512), LDS_BYTES, stream, a); }
#else
        if (ph == 2) { hipLaunchKernelGGL(k_hgrn_naive, dim3(NAIVE_WGS), dim3(128), 0, stream, a); FLUSH(); CK(3, d_out, 2 * UR); continue; }
        if (ph == 3) { hipLaunchKernelGGL(k_rglru_naive, dim3(NAIVE_WGS), dim3(128), RG_LDS, stream, a); FLUSH(); CK(4, (char*)d_ws + WS_HF, UR); CK(4, (char*)d_ws + WS_HB, UR); continue; }
#endif
        a.ph_lo = ph; a.ph_hi = ph + 1; a.li = 0;
#ifdef EXP_CKSUM
        if (ph == 0) {   }
#endif
#ifdef EXP_TEMPL
#define LP(k) case k: hipLaunchKernelGGL(mega_t<k>, dim3(grid), dim3(512), LDS_BYTES, stream, a); break;
        switch (ph) { LP(0) LP(1) LP(4) LP(5) LP(6) LP(7) LP(8) LP(9) LP(10) LP(11) LP(12) LP(13) }
#undef LP
#else
        hipLaunchKernelGGL(mega, dim3(grid), dim3(512), LDS_BYTES, stream, a); FLUSH();
#endif
#ifdef EXP_CKSUM
        { char* w = (char*)d_ws; char* o = (char*)d_out;
          switch (ph) {
            case 0: CK(1, w + WS_WINT, 18 * MiB); CK(1, o, UP); CK(1, w + WS_SMALL, 16384); CK(1, w + WS_WAT, 6 * MiB); break;
            case 1: CK(2, w + WS_XA, 5 * UP); break;
            case 4: CK(5, w + WS_A0B, UR); CK(5, w + WS_RSTDO, (size_t)MREAL * 32); break;
            case 5: CK(6, w + WS_BRA, UR); CK(6, w + WS_BRB, UR); break;
            case 6: CK(7, w + WS_SGA, UR); CK(7, w + WS_SGB, UR); break;
            case 7: CK(8, o, UR); CK(8, w + WS_W1T, 16 * MiB); break;
            case 8: CK(9, o, UR); break;
            case 9: CK(10, w + WS_X1, 2 * UR); break;
            case 10: CK(11, w + WS_A1, UR); break;
            case 11: CK(12, o, 2 * UR); CK(12, w + WS_HHI, 2 * UR); break;
            case 12: CK(13, w + WS_X1, 2 * UR); break;
            default: break; } }
#endif
    }
#ifdef EXP_CKSUM
    hipLaunchKernelGGL(k_cmp, dim3(1), dim3(64), 0, stream, (unsigned long long*)((char*)d_ws + WS_DIAG));
    hipLaunchKernelGGL(k_scale, dim3(2048), dim3(256), 0, stream, (float*)d_out, (size_t)MREAL * DM, (const unsigned long long*)((char*)d_ws + WS_DIAG));
#endif
#endif
}
```

```cpp
#include <hip/hip_runtime.h>
#include <cstdio>
#include <cstdint>
namespace pg8 {
#define PG8_LAS __attribute__((address_space(3)))
typedef unsigned short bf16_t;
typedef short bf16x8 __attribute__((ext_vector_type(8)));
typedef float f32x4 __attribute__((ext_vector_type(4)));
typedef unsigned u32x4 __attribute__((ext_vector_type(4)));
constexpr int BM = 256, BK = 64, HALF = 128, HTB = HALF * BK * 2  , STAGE_BYTES = 8 * HTB, NXCD = 8, WGM = 8;

__host__ __device__ __forceinline__ int lds_byte(int r, int c) { const int st = (r >> 4) * 2 + (c >> 5), rr = r & 15, cc = c & 31, ob = rr * 64 + cc * 2; return st * 1024 + (ob ^ (((ob >> 9) & 1) << 5)); }
__host__ __device__ __forceinline__ void stage_rc(int b, int& R, int& C) { const int st = b / 1024, sb = b % 1024, swz = sb ^ (((sb >> 9) & 1) << 5); R = (st >> 1) * 16 + swz / 64; C = (st & 1) * 32 + (swz % 64) / 2; }
__host__ __device__ __forceinline__ int perm32(int rho) { const int n = rho >> 4, i = rho & 15; return 8 * (i >> 2) + 4 * n + (i & 3); }

struct Unit { int pm, pn; };
struct Gemm { const bf16_t* A; const bf16_t* Bt; int M, N, K; const bf16_t* A2; int pm_split; };

struct StaticOrder {
    int nM, nN, nwg, G, c;
    __host__ __device__ void init(int M, int N, int G_, int c_) { nM = M / BM; nN = N / BM; nwg = nM * nN; G = G_; c = c_; }
    __host__ __device__ bool next(int i, Unit& u) const {
        const long L = (long)i * G + c; if (L >= nwg) return false;
        int wgid = (int)L; { const int q = nwg / NXCD, r = nwg % NXCD, xcd = wgid % NXCD, off = wgid / NXCD; wgid = (xcd < r ? xcd * (q + 1) : r * (q + 1) + (xcd - r) * q) + off; }
        const int nig = WGM * nN, gid = wgid / nig, fm = gid * WGM, gsz = (nM - fm) < WGM ? (nM - fm) : WGM;
        u.pm = fm + ((wgid % nig) % gsz); u.pn = (wgid % nig) / gsz; return true;
    }
    __device__ __forceinline__ void a_ready(const Unit&) const {}
    __device__ __forceinline__ void done(const Unit&) const {}
};

typedef float f32x2v __attribute__((ext_vector_type(2)));
typedef __bf16 bf16x2v __attribute__((ext_vector_type(2)));
__device__ __forceinline__ unsigned cvt_pk_bf16(float lo, float hi) { const f32x2v f = {lo, hi}; const bf16x2v b = __builtin_convertvector(f, bf16x2v); return __builtin_bit_cast(unsigned, b); }
typedef float f32x2 __attribute__((ext_vector_type(2)));
template <class F> struct EpiRow8 {
    static constexpr bool PERM = true, AFTER_DRAIN = false; F f;
    __device__ __forceinline__ void operator()(const f32x4 (&acc)[2][2][4][2], const Unit& u, int wr, int wc, int fr, int fq) const {
        const int row0 = u.pm * BM + wr * 64 + fr, col0 = u.pn * BM + wc * 32 + 8 * fq;
#pragma unroll
        for (int ai = 0; ai < 2; ++ai)
#pragma unroll
            for (int m = 0; m < 4; ++m) {
#pragma unroll
                for (int bj = 0; bj < 2; ++bj) f(row0 + ai * HALF + m * 16, col0 + bj * HALF, acc[ai][bj][m][0], acc[ai][bj][m][1]);
                if (m & 1) asm volatile("" ::: "memory"); }
    }
};
#define PG8_ABASE(pm) ((pm) < g.pm_split ? (const char*)g.A + (size_t)(pm) * tstep : (const char*)g.A2 + (size_t)((pm) - g.pm_split) * tstep)
template <class Epi, class Sched, bool ALIGN_EPI = false, bool SP2 = false>
__device__ __forceinline__ void gemm_phase(PG8_LAS unsigned char* lds, const Gemm g, const Sched& S, const Epi& E) {
    const int tid = threadIdx.x, wid = __builtin_amdgcn_readfirstlane(tid >> 6), lane = tid & 63, wr = wid >> 2, wc = wid & 3, fr = lane & 15, fq = lane >> 4;
    const int K = g.K, nt = K / BK;
    unsigned voffA[2], voffB[2];
#pragma unroll
    for (int i = 0; i < 2; ++i) { int R, C; stage_rc(tid * 16 + i * 8192, R, C); const int Rb = Epi::PERM ? ((R & ~31) + perm32(R & 31)) : R;
        voffA[i] = (unsigned)(R * K + C) * 2u; voffB[i] = (unsigned)(Rb * K + C) * 2u; }
    const size_t kstep = (size_t)(BK * 2);
    const size_t hstep = (size_t)HALF * K * 2;
    const size_t tstep = 2 * hstep;
    const unsigned ldsw = (unsigned)wid * 1024u;
    const int aoff = lds_byte(wr * 64 + fr, fq * 8), boff = lds_byte(wc * 32 + fr, fq * 8);
#define PG8_SA(b, h) (((b) * 2 + (h)) * HTB)
#define PG8_SB(b, h) ((4 + (b) * 2 + (h)) * HTB)
#define PG8_STAGE(bufoff, gbase, voff) do { _Pragma("unroll") for (int _i = 0; _i < 2; ++_i) \
        __builtin_amdgcn_global_load_lds((const unsigned*)((const char*)(gbase) + (voff)[_i]), (PG8_LAS unsigned*)(lds + (bufoff) + ldsw + _i * 8192), 16, 0, 0); } while (0)
#define PG8_LDA(dst, b, h) do { _Pragma("unroll") for (int m = 0; m < 4; ++m) _Pragma("unroll") for (int k = 0; k < 2; ++k) dst[m][k] = *(const PG8_LAS bf16x8*)(lds + PG8_SA(b, h) + aoff + m * 2048 + k * 1024); } while (0)
#define PG8_LDB(dst, b, h) do { _Pragma("unroll") for (int n = 0; n < 2; ++n) _Pragma("unroll") for (int k = 0; k < 2; ++k) dst[n][k] = *(const PG8_LAS bf16x8*)(lds + PG8_SB(b, h) + boff + n * 2048 + k * 1024); } while (0)
#define PG8_MMA(ai, bj, At, Bt) do { __builtin_amdgcn_s_setprio(1); _Pragma("unroll") for (int m = 0; m < 4; ++m) _Pragma("unroll") for (int n = 0; n < 2; ++n) _Pragma("unroll") for (int k = 0; k < 2; ++k) \
        acc[ai][bj][m][n] = __builtin_amdgcn_mfma_f32_16x16x32_bf16(Bt[n][k], At[m][k], acc[ai][bj][m][n], 0, 0, 0); __builtin_amdgcn_s_setprio(0); } while (0)
#define PG8_WAIT_V(n) asm volatile("s_waitcnt vmcnt(" #n ")" ::: "memory")
#define PG8_WAIT_L(n) asm volatile("s_waitcnt lgkmcnt(" #n ")" ::: "memory")
#define PG8_BAR __builtin_amdgcn_s_barrier()
#define PG8_SCHED __builtin_amdgcn_sched_barrier(0)
    Unit cur, nxt; int ui = 0;
    if (!S.next(0, cur)) return;
    f32x4 acc[2][2][4][2];
#pragma unroll
    for (int a = 0; a < 2; ++a)
#pragma unroll
        for (int b = 0; b < 2; ++b)
#pragma unroll
            for (int m = 0; m < 4; ++m)
#pragma unroll
                for (int n = 0; n < 2; ++n) acc[a][b][m][n] = (f32x4){0.f, 0.f, 0.f, 0.f};
    bf16x8 At[4][2], B0[2][2], B1[2][2];
    const char* cA = PG8_ABASE(cur.pm); const char* cB = (const char*)g.Bt + (size_t)cur.pn * tstep;
    S.a_ready(cur);
    if constexpr (SP2) {
        PG8_STAGE(PG8_SB(0, 0), cB, voffB); PG8_STAGE(PG8_SB(0, 1), cB + hstep, voffB); PG8_STAGE(PG8_SA(0, 0), cA, voffA); PG8_STAGE(PG8_SA(0, 1), cA + hstep, voffA);
        if (wr == 1) PG8_BAR;
        PG8_WAIT_V(2); PG8_BAR;
        PG8_STAGE(PG8_SB(1, 0), cB + kstep, voffB); PG8_STAGE(PG8_SA(1, 0), cA + kstep, voffA); PG8_STAGE(PG8_SB(1, 1), cB + hstep + kstep, voffB);
        PG8_WAIT_V(6); PG8_BAR;
    } else {
        PG8_STAGE(PG8_SB(0, 0), cB, voffB); PG8_STAGE(PG8_SA(0, 0), cA, voffA); PG8_STAGE(PG8_SB(0, 1), cB + hstep, voffB); PG8_STAGE(PG8_SA(0, 1), cA + hstep, voffA);
        if (wr == 1) PG8_BAR;
        PG8_WAIT_V(4); PG8_BAR;
        PG8_STAGE(PG8_SB(1, 0), cB + kstep, voffB); PG8_STAGE(PG8_SA(1, 0), cA + kstep, voffA); PG8_STAGE(PG8_SB(1, 1), cB + hstep + kstep, voffB);
        PG8_WAIT_V(6); PG8_BAR;
    }
    for (;;) {
        const bool has_next = S.next(ui + 1, nxt);
        const char* nA = has_next ? PG8_ABASE(nxt.pm) : cA; const char* nB = has_next ? (const char*)g.Bt + (size_t)nxt.pn * tstep : cB;
        for (int t = 0; t < nt; t += 2) {
            const bool last = (t == nt - 2);
            const char* a1 = cA + (size_t)(t + 1) * kstep;
            const char* a2 = last ? nA : cA + (size_t)(t + 2) * kstep; const char* b2 = last ? nB : cB + (size_t)(t + 2) * kstep;
            const char* a3 = a2 + kstep; const char* b3 = b2 + kstep;
            if (last && has_next) S.a_ready(nxt);
            if constexpr (SP2) {
            PG8_LDB(B0, 0, 0); PG8_LDB(B1, 0, 1); PG8_SCHED; PG8_LDA(At, 0, 0); PG8_STAGE(PG8_SA(1, 1), a1 + hstep, voffA);
            PG8_WAIT_V(8); PG8_WAIT_L(0); PG8_BAR; PG8_MMA(0, 0, At, B0); PG8_MMA(0, 1, At, B1); PG8_BAR; PG8_SCHED;
            PG8_LDA(At, 0, 1); PG8_STAGE(PG8_SB(0, 0), b2, voffB); PG8_STAGE(PG8_SB(0, 1), b2 + hstep, voffB); PG8_STAGE(PG8_SA(0, 0), a2, voffA);
            PG8_WAIT_V(8); PG8_WAIT_L(0); PG8_BAR; PG8_MMA(1, 0, At, B0); PG8_MMA(1, 1, At, B1); PG8_BAR; PG8_SCHED;
            PG8_LDB(B0, 1, 0); PG8_LDB(B1, 1, 1); PG8_SCHED; PG8_LDA(At, 1, 0); PG8_STAGE(PG8_SA(0, 1), a2 + hstep, voffA);
            PG8_WAIT_V(8); PG8_WAIT_L(0); PG8_BAR; PG8_MMA(0, 0, At, B0); PG8_MMA(0, 1, At, B1); PG8_BAR; PG8_SCHED;
            PG8_LDA(At, 1, 1); PG8_STAGE(PG8_SB(1, 0), b3, voffB); PG8_STAGE(PG8_SB(1, 1), b3 + hstep, voffB); PG8_STAGE(PG8_SA(1, 0), a3, voffA);
            PG8_WAIT_V(8); PG8_WAIT_L(0); PG8_BAR; PG8_MMA(1, 0, At, B0); PG8_MMA(1, 1, At, B1); PG8_BAR; PG8_SCHED;
            } else {
            PG8_LDB(B0, 0, 0); PG8_SCHED; PG8_LDA(At, 0, 0); PG8_STAGE(PG8_SA(1, 1), a1 + hstep, voffA);
            PG8_WAIT_L(8); PG8_BAR; PG8_WAIT_L(0); PG8_MMA(0, 0, At, B0); PG8_BAR; PG8_SCHED;
            PG8_LDB(B1, 0, 1); PG8_STAGE(PG8_SB(0, 0), b2, voffB);
            PG8_BAR; PG8_WAIT_L(0); PG8_MMA(0, 1, At, B1); PG8_BAR;
            PG8_LDA(At, 0, 1); PG8_STAGE(PG8_SA(0, 0), a2, voffA);
            PG8_BAR; PG8_WAIT_L(0); PG8_MMA(1, 0, At, B0); PG8_BAR; PG8_SCHED;
            PG8_STAGE(PG8_SB(0, 1), b2 + hstep, voffB);
            PG8_WAIT_V(6); PG8_BAR; PG8_MMA(1, 1, At, B1); PG8_BAR;
            PG8_LDB(B0, 1, 0); PG8_SCHED; PG8_LDA(At, 1, 0); PG8_STAGE(PG8_SA(0, 1), a2 + hstep, voffA);
            PG8_WAIT_L(8); PG8_BAR; PG8_WAIT_L(0); PG8_MMA(0, 0, At, B0); PG8_BAR; PG8_SCHED;
            PG8_LDB(B1, 1, 1); PG8_STAGE(PG8_SB(1, 0), b3, voffB);
            PG8_BAR; PG8_WAIT_L(0); PG8_MMA(0, 1, At, B1); PG8_BAR;
            PG8_LDA(At, 1, 1); PG8_STAGE(PG8_SA(1, 0), a3, voffA);
            PG8_BAR; PG8_WAIT_L(0); PG8_MMA(1, 0, At, B0); PG8_BAR; PG8_SCHED;
            PG8_STAGE(PG8_SB(1, 1), b3 + hstep, voffB);
            PG8_WAIT_V(6); PG8_BAR; PG8_MMA(1, 1, At, B1); PG8_BAR;
            }
        }
        if constexpr (ALIGN_EPI) { if (wr == 0) PG8_BAR; }
        if constexpr (!Epi::AFTER_DRAIN) { E(acc, cur, wr, wc, fr, fq); S.done(cur); }
        if (!has_next) break;
#pragma unroll
        for (int a = 0; a < 2; ++a)
#pragma unroll
            for (int b = 0; b < 2; ++b)
#pragma unroll
                for (int m = 0; m < 4; ++m)
#pragma unroll
                    for (int n = 0; n < 2; ++n) acc[a][b][m][n] = (f32x4){0.f, 0.f, 0.f, 0.f};
        cur = nxt; cA = nA; cB = nB; ++ui;
        if constexpr (ALIGN_EPI) { if (wr == 1) PG8_BAR; }
    }
    PG8_WAIT_V(0);
    if constexpr (!ALIGN_EPI) { if (wr == 0) PG8_BAR; }
    PG8_BAR;
    if constexpr (Epi::AFTER_DRAIN) { E.fused(acc, cur, wr, wc, fr, fq, lds, wid, lane); S.done(cur); }
#undef PG8_SA
#undef PG8_SB
#undef PG8_STAGE
#undef PG8_LDA
#undef PG8_LDB
#undef PG8_MMA
#undef PG8_WAIT_V
#undef PG8_WAIT_L
#undef PG8_BAR
#undef PG8_SCHED
}
}

constexpr int DM = 1024, NSEQ = 6, SEQ = 8192, NMETA = 16, LTOT = SEQ + NMETA;
constexpr int MREAL = NSEQ * SEQ;
constexpr int MPAD = MREAL + 256;
constexpr int NPROMPT_ROWS = 2 * SEQ;
constexpr int NIN = 9216, NIN1 = 5120, DFF = 4096;
constexpr float EPS = 1e-6f;
constexpr size_t MiB = 1u << 20;
constexpr size_t UP = (size_t)MPAD * DM * 2;
constexpr size_t UR = (size_t)MREAL * DM * 2;
constexpr size_t WS_CTL = 0, CTL_BYTES = 1 * MiB;
constexpr size_t WS_WINT = 1 * MiB;
constexpr size_t WS_W1T = 1 * MiB, WS_W2T = 9 * MiB;
constexpr size_t WS_SMALL = 20 * MiB;
constexpr size_t WS_RSTDO = 21 * MiB;
constexpr size_t WS_WAT = 23 * MiB, WS_WBT = 25 * MiB, WS_WOT = 27 * MiB;
constexpr size_t WS_R0 = 29 * MiB;
constexpr size_t WS_XA = WS_R0, WS_Q = WS_R0 + UP, WS_GF = WS_R0 + 2 * UP, WS_GB = WS_R0 + 3 * UP, WS_V = WS_R0 + 4 * UP;
constexpr size_t WS_HF = WS_Q, WS_HB = WS_GF;
constexpr size_t WS_A0B = WS_XA;
constexpr size_t WS_BRA = WS_GB, WS_BRB = WS_V;
constexpr size_t WS_SGA = WS_Q, WS_SGB = WS_GF;
constexpr size_t WS_X1 = WS_R0, WS_A1 = WS_R0 + 2 * UR, WS_HHI = WS_R0 + 3 * UR;
constexpr size_t WS_END = WS_R0 + 5 * UP;
static_assert(WS_END <= 512 * MiB, "workspace map");
constexpr int HSPLIT_PM = MREAL / 256 / 2;
constexpr size_t OUT_OB = UR;
constexpr int CW_BAR = 4096;

typedef unsigned short bf16;
typedef float f32x4 __attribute__((ext_vector_type(4)));
typedef unsigned u32x4 __attribute__((ext_vector_type(4)));
typedef unsigned u32x2 __attribute__((ext_vector_type(2)));
#define LAS __attribute__((address_space(3)))

struct Args { const float* in[21]; float* out; unsigned char* ws; int ph_lo, ph_hi, li, pad; };

__device__ __forceinline__ float bf2f(unsigned v) { return __uint_as_float(v << 16); }
__device__ __forceinline__ unsigned f2bf(float f) { unsigned u = __float_as_uint(f); return (u + 0x7fffu + ((u >> 16) & 1u)) >> 16; }
__device__ __forceinline__ unsigned pk2(float lo, float hi) { return f2bf(lo) | (f2bf(hi) << 16); }
__device__ __forceinline__ float fsigmoid(float x) { return __builtin_amdgcn_rcpf(1.f + __expf(-x)); }
__device__ __forceinline__ float wave_sum(float v) {
#pragma unroll
    for (int o = 1; o < 64; o <<= 1) v += __shfl_xor(v, o);
    return v;
}
__device__ __forceinline__ void unpack8(u32x4 w, float (&o)[8]) {
    o[0] = __uint_as_float(w.x << 16); o[1] = __uint_as_float(w.x & 0xffff0000u); o[2] = __uint_as_float(w.y << 16); o[3] = __uint_as_float(w.y & 0xffff0000u);
    o[4] = __uint_as_float(w.z << 16); o[5] = __uint_as_float(w.z & 0xffff0000u); o[6] = __uint_as_float(w.w << 16); o[7] = __uint_as_float(w.w & 0xffff0000u);
}
__device__ __forceinline__ u32x4 pack8(const float (&v)[8]) {
    u32x4 w; w.x = pg8::cvt_pk_bf16(v[0], v[1]); w.y = pg8::cvt_pk_bf16(v[2], v[3]); w.z = pg8::cvt_pk_bf16(v[4], v[5]); w.w = pg8::cvt_pk_bf16(v[6], v[7]); return w;
}
__device__ __forceinline__ const float* xrow_ptr(const Args& a, int r) { return r < NPROMPT_ROWS ? a.in[0] + (size_t)r * DM : a.in[1] + (size_t)(r - NPROMPT_ROWS) * DM; }

struct FP1 { bf16* base; const float* lb;
    __device__ __forceinline__ void operator()(int row, int col, f32x4 v0, f32x4 v1) const {
        const int cg = col >> 10, c = col & 1023;
        float v[8] = {v0[0], v0[1], v0[2], v0[3], v1[0], v1[1], v1[2], v1[3]};
        if (cg == 1) {
#pragma unroll
            for (int j = 0; j < 8; ++j) v[j] = v[j] * fsigmoid(v[j]);
        } else if (cg == 2 || cg == 3) {
            const float* l = lb + (cg - 2) * DM + c; const f32x4 l0 = *(const f32x4*)l, l1 = *(const f32x4*)(l + 4);
            const float lv[8] = {l0[0], l0[1], l0[2], l0[3], l1[0], l1[1], l1[2], l1[3]};
#pragma unroll
            for (int j = 0; j < 8; ++j) v[j] = __logf(lv[j] + (1.f - lv[j]) * fsigmoid(v[j]));
        }
        *(u32x4*)(base + (size_t)cg * (UP / 2) + (size_t)row * DM + c) = pack8(v);
    }
};
struct FP5a { const bf16* hf; const bf16* hb; const bf16* of; const bf16* ob; const float* rstdo; const float* hgg; bf16* bra; bf16* brb;
    __device__ __forceinline__ void operator()(int row, int col, f32x4 v0, f32x4 v1) const {
        const int cg = col >> 10, c = col & 1023; const size_t off = (size_t)row * DM + c;
        float v[8] = {v0[0], v0[1], v0[2], v0[3], v1[0], v1[1], v1[2], v1[3]};
        if (cg == 0) {
#ifdef EXP_V1SCAN
            float h[8], h2[8]; unpack8(*(const u32x4*)(of + (size_t)row * 2048 + c), h);
#pragma unroll
            for (int j = 0; j < 8; ++j) h2[j] = 0.f;
#else
            float h[8], h2[8]; unpack8(*(const u32x4*)(hf + off), h); unpack8(*(const u32x4*)(hb + off), h2);
#endif
#pragma unroll
            for (int j = 0; j < 8; ++j) { const float x = v[j]; v[j] = (h[j] + h2[j]) * x * fsigmoid(1.5957691216057308f * (x + 0.044715f * x * x * x)); }
            *(u32x4*)(bra + off) = pack8(v);
        } else {
#ifdef EXP_V1SCAN
            float o[8], o2[8]; unpack8(*(const u32x4*)(of + (size_t)row * 2048 + 1024 + c), o);
#pragma unroll
            for (int j = 0; j < 8; ++j) o2[j] = 0.f;
#else
            float o[8], o2[8]; unpack8(*(const u32x4*)(of + off), o); unpack8(*(const u32x4*)(ob + off), o2);
#endif
            const float rs = rstdo[(size_t)row * 8 + (c >> 7)];
            const f32x4 g0 = *(const f32x4*)(hgg + c), g1 = *(const f32x4*)(hgg + c + 4);
            const float gv[8] = {g0[0], g0[1], g0[2], g0[3], g1[0], g1[1], g1[2], g1[3]};
#pragma unroll
            for (int j = 0; j < 8; ++j) v[j] = (o[j] + o2[j]) * rs * gv[j] * (v[j] * fsigmoid(v[j]));
            *(u32x4*)(brb + off) = pack8(v);
        }
    }
};
struct FP5b { bf16* sga; bf16* sgb; const float* dmy;
    __device__ __forceinline__ void operator()(int row, int col, f32x4 v0, f32x4 v1) const {
        const int cg = col >> 10, c = col & 1023;
        float v[8] = {v0[0], v0[1], v0[2], v0[3], v1[0], v1[1], v1[2], v1[3]};
#ifdef EXP_SLEEP
        __builtin_amdgcn_s_sleep(127);
#endif
#ifdef EXP_DLOAD
        const f32x4 dz = *(const f32x4*)(dmy + c);
#pragma unroll
        for (int j = 0; j < 8; ++j) v[j] = fsigmoid(v[j]) + 0.f * dz[j & 3];
#else
#pragma unroll
        for (int j = 0; j < 8; ++j) v[j] = fsigmoid(v[j]);
#endif
        *(u32x4*)((cg == 0 ? sga : sgb) + (size_t)row * DM + c) = pack8(v);
    }
};
struct FP3b1 { const bf16* sg; bf16* t1;
    __device__ __forceinline__ void operator()(int row, int col, f32x4 v0, f32x4 v1) const {
        float v[8] = {v0[0], v0[1], v0[2], v0[3], v1[0], v1[1], v1[2], v1[3]}; float s[8]; unpack8(*(const u32x4*)(sg + (size_t)row * DM + col), s);
#pragma unroll
        for (int j = 0; j < 8; ++j) v[j] *= s[j];
        *(u32x4*)(t1 + (size_t)row * DM + col) = pack8(v);
    }
};
struct FP3b2 { const bf16* sg; bf16* t1;
    __device__ __forceinline__ void operator()(int row, int col, f32x4 v0, f32x4 v1) const {
        float v[8] = {v0[0], v0[1], v0[2], v0[3], v1[0], v1[1], v1[2], v1[3]}; float s[8], t[8];
        unpack8(*(const u32x4*)(sg + (size_t)row * DM + col), s); unpack8(*(const u32x4*)(t1 + (size_t)row * DM + col), t);
#pragma unroll
        for (int j = 0; j < 8; ++j) v[j] = t[j] + v[j] * s[j];
        *(u32x4*)(t1 + (size_t)row * DM + col) = pack8(v);
    }
};
struct FP3c { const float* xp; const float* xs; float* x1;
    __device__ __forceinline__ void operator()(int row, int col, f32x4 v0, f32x4 v1) const {
        const float* xr = (row < NPROMPT_ROWS ? xp + (size_t)row * DM : xs + (size_t)(row - NPROMPT_ROWS) * DM) + col;
        float* o = x1 + (size_t)row * DM + col;
        *(f32x4*)o = *(const f32x4*)xr + v0; *(f32x4*)(o + 4) = *(const f32x4*)(xr + 4) + v1;
    }
};
struct FP4 { bf16* hlo; bf16* hhi;
    __device__ __forceinline__ void operator()(int row, int col, f32x4 v0, f32x4 v1) const {
        float v[8] = {v0[0], v0[1], v0[2], v0[3], v1[0], v1[1], v1[2], v1[3]};
#pragma unroll
        for (int j = 0; j < 8; ++j) { const float r = fmaxf(v[j], 0.f); v[j] = r * r; }
        bf16* o = row < HSPLIT_PM * 256 ? hlo + (size_t)row * DFF : hhi + (size_t)(row - HSPLIT_PM * 256) * DFF;
        *(u32x4*)(o + col) = pack8(v);
    }
};
struct FP5 { float* x1;
    __device__ __forceinline__ void operator()(int row, int col, f32x4 v0, f32x4 v1) const {
        float* o = x1 + (size_t)row * DM + col;
        *(f32x4*)o = *(const f32x4*)o + v0; *(f32x4*)(o + 4) = *(const f32x4*)(o + 4) + v1;
    }
};

#define XB_TMO      128
#define XB_XCNT(j)  (256  + 64 * (j))
#define XB_XSUB(j)  (1280 + 64 * (j))
#define XB_XGEN(j)  (2304 + 64 * (j))
#define XB_TOP      3328
#define XB_TOPGEN   3392
#define XCD_BAR_WORDS 3456
#define XB_SPIN_CAP (1u << 22)

__device__ __forceinline__ unsigned xb_ld(unsigned* p)              { return __hip_atomic_load(p, __ATOMIC_RELAXED, __HIP_MEMORY_SCOPE_AGENT); }
__device__ __forceinline__ unsigned xb_add(unsigned* p, unsigned v) { return __hip_atomic_fetch_add(p, v, __ATOMIC_RELAXED, __HIP_MEMORY_SCOPE_AGENT); }
__device__ __forceinline__ unsigned xb_xcc_id() { return (unsigned)__builtin_amdgcn_s_getreg((3 << 11) | 20) & 0xFu; }
#define XB_SPIN(cond, bar) do { unsigned _sp = 0; while (cond) { __builtin_amdgcn_s_sleep(1); \
    if ((++_sp & 255u) == 0u) { if (xb_ld(&(bar)[XB_TMO])) break; if (_sp > XB_SPIN_CAP) { atomicAdd(&(bar)[XB_TMO], 1u); break; } } } } while (0)

struct XcdBarrier {
    unsigned* bar; unsigned x;
    volatile LAS unsigned* st;
};

__device__ __forceinline__ XcdBarrier xcd_barrier_post(unsigned* bar, volatile LAS unsigned* st) {
    XcdBarrier b; b.bar = bar; b.x = xb_xcc_id(); b.st = st;
    if (threadIdx.x == 0) (void)xb_add(&bar[XB_XCNT(b.x)], 1u);
    return b;
}
__device__ __forceinline__ void xcd_barrier_complete(unsigned* bar, unsigned x, unsigned& nloc, unsigned& nx) {
    const unsigned G = gridDim.x * gridDim.y * gridDim.z;
    unsigned sum, cnt, mine, sp = 0u;
    for (;;) {
        sum = 0u; cnt = 0u; mine = 0u;
#pragma unroll
        for (unsigned j = 0; j < 16; ++j) { const unsigned c = xb_ld(&bar[XB_XCNT(j)]); sum += c; cnt += (c > 0u) ? 1u : 0u; mine = (j == x) ? c : mine; }
        if (sum == G) break;
        __builtin_amdgcn_s_sleep(1);
        if ((++sp & 255u) == 0u) { if (xb_ld(&bar[XB_TMO])) break; if (sp > XB_SPIN_CAP) { atomicAdd(&bar[XB_TMO], 1u); break; } }
    }
    nloc = mine > 0u ? mine : 1u; nx = cnt > 0u ? cnt : 1u;
}

__device__ __forceinline__ void xcd_barrier(const XcdBarrier& b) {
    asm volatile("s_waitcnt vmcnt(0)" ::: "memory");
    __syncthreads();
    if (threadIdx.x == 0) {
        unsigned* bar = b.bar;
        __builtin_amdgcn_s_waitcnt(0);
        unsigned nloc = b.st[0], nx = b.st[1];
        if (nloc == 0u) { xcd_barrier_complete(bar, b.x, nloc, nx); b.st[0] = nloc; b.st[1] = nx; }
        const unsigned old = xb_add(&bar[XB_XSUB(b.x)], 1u);
        const unsigned gen = old / nloc;
        if (old + 1u == (gen + 1u) * nloc) {
            __builtin_amdgcn_fence(__ATOMIC_RELEASE, "agent");
            asm volatile("s_waitcnt vmcnt(0)" ::: "memory");
            const unsigned og = xb_add(&bar[XB_TOP], 1u);
            const unsigned tg = og / nx;
            if (og + 1u == (tg + 1u) * nx) xb_add(&bar[XB_TOPGEN], 1u);
            else XB_SPIN(xb_ld(&bar[XB_TOPGEN]) == tg, bar);
            __builtin_amdgcn_fence(__ATOMIC_ACQUIRE, "agent");
            xb_add(&bar[XB_XGEN(b.x)], 1u);
            asm volatile("s_waitcnt vmcnt(0)" ::: "memory");
        } else {
            XB_SPIN(xb_ld(&bar[XB_XGEN(b.x)]) == gen, bar);
            __builtin_amdgcn_fence(__ATOMIC_ACQUIRE, "agent");
            asm volatile("s_waitcnt vmcnt(0)" ::: "memory");
        }
    }
    __syncthreads();
}

typedef short bf16x8s __attribute__((ext_vector_type(8)));
__device__ __forceinline__ bf16x8s mk8(u32x4 w) { return __builtin_bit_cast(bf16x8s, w); }
__device__ __forceinline__ bf16x8s mk8(u32x2 lo, u32x2 hi) { u32x4 w; w.x = lo.x; w.y = lo.y; w.z = hi.x; w.w = hi.y; return __builtin_bit_cast(bf16x8s, w); }
__device__ __forceinline__ bf16x8s pack8f(f32x4 a, f32x4 b) { u32x4 w; w.x = pg8::cvt_pk_bf16(a[0], a[1]); w.y = pg8::cvt_pk_bf16(a[2], a[3]); w.z = pg8::cvt_pk_bf16(b[0], b[1]); w.w = pg8::cvt_pk_bf16(b[2], b[3]); return __builtin_bit_cast(bf16x8s, w); }
__device__ __forceinline__ bf16 bf1(float x) { return (bf16)(pg8::cvt_pk_bf16(x, x) & 0xffffu); }
#define MFMA16(a, b, c) __builtin_amdgcn_mfma_f32_16x16x32_bf16((a), (b), (c), 0, 0, 0)

constexpr int HG_PITCH = 272;
constexpr int HG_TP = 80;
constexpr int HG_RAWQ = 0, HG_RAWG = 8704, HG_RAWV = 17408, HG_QD = 26112, HG_KD = 34816, HG_KDT = 43520, HG_VT = 53760, HG_TG = 64000, HG_F = 66048, HG_E = 66560;
__device__ __forceinline__ long hg_row(int dir, int s, int u) { return dir == 0 ? (u < 16 ? -1L : (u < 32 ? (long)(MREAL + u - 16) : (long)s * SEQ + (u - 32))) : (long)s * SEQ + (SEQ - 1 - u); }

__device__ __forceinline__ void phase_hgrn(const Args& a, LAS unsigned char* L, int item, int tid) {
    const int dir = item / 48, s = (item % 48) / 8, hd = item % 8;
    const int lane = tid & 63, w = __builtin_amdgcn_readfirstlane(tid >> 6), i = lane & 15, h = lane >> 4;
    unsigned char* ws = a.ws;
    const bf16* Q = (const bf16*)(ws + WS_Q) + hd * 128; const bf16* G = (const bf16*)(ws + (dir == 0 ? WS_GF : WS_GB)) + hd * 128; const bf16* V = (const bf16*)(ws + WS_V) + hd * 128;
    bf16* O = (bf16*)((unsigned char*)a.out + (dir == 0 ? 0 : OUT_OB)) + hd * 128;
    const int nchunk = dir == 0 ? 257 : 256;
    const int srow = tid >> 4, scc = tid & 15;
    const int pk = tid & 127, ptg = tid >> 7;
    u32x4 rq, rg, rv;
    { const long r = hg_row(dir, s, srow); const u32x4 z = {0u, 0u, 0u, 0u};
      rq = r < 0 ? z : *(const u32x4*)(Q + r * DM + 8 * scc); rg = r < 0 ? z : *(const u32x4*)(G + r * DM + 8 * scc); rv = r < 0 ? z : *(const u32x4*)(V + r * DM + 8 * scc); }
    *(LAS u32x4*)(L + HG_RAWQ + srow * HG_PITCH + 16 * scc) = rq; *(LAS u32x4*)(L + HG_RAWG + srow * HG_PITCH + 16 * scc) = rg; *(LAS u32x4*)(L + HG_RAWV + srow * HG_PITCH + 16 * scc) = rv;
    __syncthreads();
    f32x4 S[8];
#pragma unroll
    for (int kt = 0; kt < 8; ++kt) S[kt] = (f32x4){0.f, 0.f, 0.f, 0.f};
    for (int c = 0; c < nchunk; ++c) {
        if (c + 1 < nchunk) { const long r = hg_row(dir, s, 32 * (c + 1) + srow);
            rq = *(const u32x4*)(Q + r * DM + 8 * scc); rg = *(const u32x4*)(G + r * DM + 8 * scc); rv = *(const u32x4*)(V + r * DM + 8 * scc); }
        float gj[8], cs[8];
#pragma unroll
        for (int j = 0; j < 8; ++j) gj[j] = bf2f(*(const LAS bf16*)(L + HG_RAWG + (8 * ptg + j) * HG_PITCH + 2 * pk));
        cs[0] = gj[0];
#pragma unroll
        for (int j = 1; j < 8; ++j) cs[j] = cs[j - 1] + gj[j];
        ((LAS float*)(L + HG_TG))[ptg * 128 + pk] = cs[7];
        __syncthreads();
        { const float T0 = ((const LAS float*)(L + HG_TG))[pk], T1 = ((const LAS float*)(L + HG_TG))[128 + pk], T2 = ((const LAS float*)(L + HG_TG))[256 + pk], T3 = ((const LAS float*)(L + HG_TG))[384 + pk];
          const float base = ptg == 0 ? 0.f : ptg == 1 ? T0 : ptg == 2 ? T0 + T1 : T0 + T1 + T2; const float bmid = T0 + T1, blast = bmid + T2 + T3;
          float kdv[8], vv[8];
#pragma unroll
          for (int j = 0; j < 8; ++j) { const float b = base + cs[j]; const float e = __expf(b - bmid), einv = __expf(bmid - b), kk = 1.f - __expf(gj[j]);
              const float qv = bf2f(*(const LAS bf16*)(L + HG_RAWQ + (8 * ptg + j) * HG_PITCH + 2 * pk));
              vv[j] = bf2f(*(const LAS bf16*)(L + HG_RAWV + (8 * ptg + j) * HG_PITCH + 2 * pk));
              kdv[j] = kk * einv;
              *(LAS bf16*)(L + HG_QD + (8 * ptg + j) * HG_PITCH + 2 * pk) = bf1(qv * e); *(LAS bf16*)(L + HG_KD + (8 * ptg + j) * HG_PITCH + 2 * pk) = bf1(kdv[j]); }
          *(LAS u32x4*)(L + HG_KDT + pk * HG_TP + 16 * ptg) = pack8(kdv); *(LAS u32x4*)(L + HG_VT + pk * HG_TP + 16 * ptg) = pack8(vv);
          if (ptg == 0) { ((LAS float*)(L + HG_F))[pk] = __expf(bmid); ((LAS float*)(L + HG_E))[pk] = __expf(blast - bmid); } }
        __syncthreads();
        if (c + 1 < nchunk) { *(LAS u32x4*)(L + HG_RAWQ + srow * HG_PITCH + 16 * scc) = rq; *(LAS u32x4*)(L + HG_RAWG + srow * HG_PITCH + 16 * scc) = rg; *(LAS u32x4*)(L + HG_RAWV + srow * HG_PITCH + 16 * scc) = rv; }
        bf16x8s Bs[4];
#pragma unroll
        for (int kt = 0; kt < 8; ++kt) S[kt] = S[kt] * *(const LAS f32x4*)(L + HG_F + (16 * kt + 4 * h) * 4);
#pragma unroll
        for (int ks = 0; ks < 4; ++ks) Bs[ks] = pack8f(S[2 * ks], S[2 * ks + 1]);
        f32x4 acc0 = {0.f, 0.f, 0.f, 0.f}, acc1 = {0.f, 0.f, 0.f, 0.f};
        f32x4 pt00 = {0.f, 0.f, 0.f, 0.f}, pt10 = {0.f, 0.f, 0.f, 0.f}, pt11 = {0.f, 0.f, 0.f, 0.f};
#pragma unroll
        for (int ks = 0; ks < 4; ++ks) {
            const LAS unsigned char* q0 = L + HG_QD + i * HG_PITCH + (32 * ks + 4 * h) * 2; const LAS unsigned char* q1 = q0 + 16 * HG_PITCH;
            acc0 = MFMA16(mk8(*(const LAS u32x2*)q0, *(const LAS u32x2*)(q0 + 32)), Bs[ks], acc0);
            acc1 = MFMA16(mk8(*(const LAS u32x2*)q1, *(const LAS u32x2*)(q1 + 32)), Bs[ks], acc1);
            const bf16x8s kd0 = mk8(*(const LAS u32x4*)(L + HG_KD + i * HG_PITCH + (32 * ks + 8 * h) * 2)), kd1 = mk8(*(const LAS u32x4*)(L + HG_KD + (16 + i) * HG_PITCH + (32 * ks + 8 * h) * 2));
            const bf16x8s qd0 = mk8(*(const LAS u32x4*)(L + HG_QD + i * HG_PITCH + (32 * ks + 8 * h) * 2)), qd1 = mk8(*(const LAS u32x4*)(L + HG_QD + (16 + i) * HG_PITCH + (32 * ks + 8 * h) * 2));
            pt00 = MFMA16(kd0, qd0, pt00); pt10 = MFMA16(kd0, qd1, pt10); pt11 = MFMA16(kd1, qd1, pt11);
        }
#pragma unroll
        for (int r = 0; r < 4; ++r) if (4 * h + r > i) { pt00[r] = 0.f; pt11[r] = 0.f; }
        { const f32x4 z = {0.f, 0.f, 0.f, 0.f};
          const LAS unsigned char* vp = L + HG_VT + (16 * w + i) * HG_TP + 8 * h;
          const bf16x8s Bv = mk8(*(const LAS u32x2*)vp, *(const LAS u32x2*)(vp + 32));
          acc0 = MFMA16(pack8f(pt00, z), Bv, acc0); acc1 = MFMA16(pack8f(pt10, pt11), Bv, acc1); }
        { const bf16x8s Bv2 = mk8(*(const LAS u32x4*)(L + HG_VT + (16 * w + i) * HG_TP + 16 * h));
#pragma unroll
          for (int kt = 0; kt < 8; ++kt) S[kt] = MFMA16(mk8(*(const LAS u32x4*)(L + HG_KDT + (16 * kt + i) * HG_TP + 16 * h)), Bv2, S[kt]);
#pragma unroll
          for (int kt = 0; kt < 8; ++kt) S[kt] = S[kt] * *(const LAS f32x4*)(L + HG_E + (16 * kt + 4 * h) * 4); }
        if (dir == 1 || c > 0) {
#pragma unroll
            for (int r = 0; r < 4; ++r) { const int u0 = 32 * c + 4 * h + r;
                const long r0 = hg_row(dir, s, u0), r1 = hg_row(dir, s, u0 + 16);
                O[r0 * DM + 16 * w + i] = bf1(acc0[r]); O[r1 * DM + 16 * w + i] = bf1(acc1[r]); }
        }
        __syncthreads();
    }
}

constexpr int RG_PITCH = 272;
constexpr int RG_RAW = 0, RG_XC = 36 * 272;
__device__ __forceinline__ long rg_row(int s, int p) { return (p < 0 || p >= LTOT) ? -1L : (p < NMETA ? (long)(MREAL + p) : (long)s * SEQ + (p - NMETA)); }

__device__ __forceinline__ void phase_rglru(const Args& a, LAS unsigned char* L, int item, int tid) {
    const int dir = item / 48, s = (item % 48) / 8, hb = item % 8;
    const int lane = tid & 63, w = __builtin_amdgcn_readfirstlane(tid >> 6), i = lane & 15, h = lane >> 4;
    unsigned char* ws = a.ws;
    const bf16* XA = (const bf16*)(ws + WS_XA) + hb * 128; bf16* HO = (bf16*)(ws + (dir == 0 ? WS_HF : WS_HB)) + hb * 128;
    bf16x8s Ba[4], Bx[4];
    { const float* wa = a.in[8] + (size_t)(dir * 8 + hb) * 16384 + 16 * w + i; const float* wx = a.in[10] + (size_t)(dir * 8 + hb) * 16384 + 16 * w + i;
#pragma unroll
      for (int ks = 0; ks < 4; ++ks) { float t[8], x[8];
#pragma unroll
          for (int j = 0; j < 8; ++j) { t[j] = wa[(size_t)(32 * ks + 8 * h + j) * 128]; x[j] = wx[(size_t)(32 * ks + 8 * h + j) * 128]; }
          Ba[ks] = mk8(pack8(t)); Bx[ks] = mk8(pack8(x)); } }
    const int C = hb * 128 + 16 * w + i;
    const float ba = a.in[9][dir * DM + C], bx = a.in[11][dir * DM + C], cl = ((const float*)(ws + WS_SMALL))[2048 + dir * DM + C];
    const int ck = tid & 127, ctq = tid >> 7, CC = hb * 128 + ck;
    const float cw0 = a.in[6][CC], cw1 = a.in[6][DM + CC], cw2 = a.in[6][2 * DM + CC], cw3 = a.in[6][3 * DM + CC], cb = a.in[7][CC];
    const int ntile = dir == 0 ? 257 : 256;
    const int srow = tid >> 4, scc = tid & 15;
    float hc = 0.f;
    u32x4 r0v, r1v; const u32x4 z4 = {0u, 0u, 0u, 0u};
    { const int P0 = dir == 0 ? -16 : 8176; const long ra = rg_row(s, P0 - 2 + srow), rb = rg_row(s, P0 - 2 + 32 + srow);
      r0v = ra < 0 ? z4 : *(const u32x4*)(XA + ra * DM + 8 * scc); r1v = (tid < 64 && rb >= 0) ? *(const u32x4*)(XA + rb * DM + 8 * scc) : z4; }
    for (int c = 0; c < ntile; ++c) {
        const int P0 = dir == 0 ? 32 * c - 16 : 8176 - 32 * c;
        *(LAS u32x4*)(L + RG_RAW + srow * RG_PITCH + 16 * scc) = r0v; if (tid < 64) *(LAS u32x4*)(L + RG_RAW + (32 + srow) * RG_PITCH + 16 * scc) = r1v;
        __syncthreads();
        if (c + 1 < ntile) { const int P1 = dir == 0 ? P0 + 32 : P0 - 32; const long ra = rg_row(s, P1 - 2 + srow), rb = rg_row(s, P1 - 2 + 32 + srow);
            r0v = ra < 0 ? z4 : *(const u32x4*)(XA + ra * DM + 8 * scc); r1v = (tid < 64 && rb >= 0) ? *(const u32x4*)(XA + rb * DM + 8 * scc) : z4; }
        { float xr[11];
          const int pb = dir == 0 ? 8 * ctq : 24 - 8 * ctq;
#pragma unroll
          for (int m = 0; m < 11; ++m) xr[m] = bf2f(*(const LAS bf16*)(L + RG_RAW + (pb + m) * RG_PITCH + 2 * ck));
#pragma unroll
          for (int q = 0; q < 8; ++q) { const float xc = cb + cw0 * xr[q] + cw1 * xr[q + 1] + cw2 * xr[q + 2] + cw3 * xr[q + 3];
              const int tau = dir == 0 ? pb + q : 31 - (pb + q);
              *(LAS bf16*)(L + RG_XC + tau * RG_PITCH + 2 * ck) = bf1(xc); } }
        __syncthreads();
        f32x4 aa0 = {0.f, 0.f, 0.f, 0.f}, aa1 = aa0, ax0 = aa0, ax1 = aa0;
#pragma unroll
        for (int ks = 0; ks < 4; ++ks) { const bf16x8s A0 = mk8(*(const LAS u32x4*)(L + RG_XC + i * RG_PITCH + (32 * ks + 8 * h) * 2)), A1 = mk8(*(const LAS u32x4*)(L + RG_XC + (16 + i) * RG_PITCH + (32 * ks + 8 * h) * 2));
            aa0 = MFMA16(A0, Ba[ks], aa0); aa1 = MFMA16(A1, Ba[ks], aa1); ax0 = MFMA16(A0, Bx[ks], ax0); ax1 = MFMA16(A1, Bx[ks], ax1); }
#pragma unroll
        for (int mt = 0; mt < 2; ++mt) {
            const f32x4 pa = mt == 0 ? aa0 : aa1, px = mt == 0 ? ax0 : ax1; float av[4], uv[4];
#pragma unroll
            for (int r = 0; r < 4; ++r) { const int tau = 16 * mt + 4 * h + r; const int p = dir == 0 ? P0 + tau : P0 + 31 - tau;
                const float rgt = __builtin_amdgcn_rcpf(1.f + __expf(-(pa[r] + ba))), igt = __builtin_amdgcn_rcpf(1.f + __expf(-(px[r] + bx)));
                const float aval = __expf(cl * rgt); const float mult = __builtin_amdgcn_sqrtf(fmaxf(1.f - aval * aval, 0.f));
                const float xcv = bf2f(*(const LAS bf16*)(L + RG_XC + tau * RG_PITCH + 2 * (16 * w + i)));
                av[r] = aval; uv[r] = p < 0 ? 0.f : mult * igt * xcv; }
            float A = av[0] * av[1] * av[2] * av[3], B = ((uv[0] * av[1] + uv[1]) * av[2] + uv[2]) * av[3] + uv[3];
            { const float A1 = __shfl(A, (lane - 16) & 63), B1 = __shfl(B, (lane - 16) & 63); if (h >= 1) { B = A * B1 + B; A = A * A1; } }
            { const float A2 = __shfl(A, (lane - 32) & 63), B2 = __shfl(B, (lane - 32) & 63); if (h >= 2) { B = A * B2 + B; A = A * A2; } }
            float Ae = __shfl(A, (lane - 16) & 63), Be = __shfl(B, (lane - 16) & 63); if (h == 0) { Ae = 1.f; Be = 0.f; }
            float st = Ae * hc + Be;
#pragma unroll
            for (int r = 0; r < 4; ++r) { st = av[r] * st + uv[r]; const int tau = 16 * mt + 4 * h + r; const int p = dir == 0 ? P0 + tau : P0 + 31 - tau;
                if (p >= NMETA) HO[((long)s * SEQ + (p - NMETA)) * DM + 16 * w + i] = bf1(st); }
            hc = __shfl(st, 48 + i);
        }
        __syncthreads();
    }
}

__device__ __forceinline__ void transpose_item(const float* W, int K, int N, bf16* WT, int k0, int n0, int dst_row0, float* scr, int lane) {
#pragma unroll 8
    for (int i = 0; i < 32; ++i) { const int kk = 2 * i + (lane >> 5); scr[kk * 33 + (lane & 31)] = W[(size_t)(k0 + kk) * N + n0 + (lane & 31)]; }
    asm volatile("s_waitcnt lgkmcnt(0)" ::: "memory");
    const int c = lane & 7;
#pragma unroll
    for (int j = 0; j < 4; ++j) { const int n = (lane >> 3) + 8 * j; const float* s = scr + (8 * c) * 33 + n;
        u32x4 o; o.x = pk2(s[0 * 33], s[1 * 33]); o.y = pk2(s[2 * 33], s[3 * 33]); o.z = pk2(s[4 * 33], s[5 * 33]); o.w = pk2(s[6 * 33], s[7 * 33]);
        *(u32x4*)(WT + (size_t)(dst_row0 + n) * K + k0 + 8 * c) = o; }
    asm volatile("s_waitcnt lgkmcnt(0)" ::: "memory");
}
__device__ __forceinline__ void norm_row_bf16(const float* xrow, const float* gain, bf16* orow, int lane) {
    const f32x4* xr = (const f32x4*)xrow + lane; f32x4 v[4]; float s = 0.f;
#pragma unroll
    for (int j = 0; j < 4; ++j) { v[j] = xr[64 * j]; s += (v[j].x * v[j].x + v[j].y * v[j].y) + (v[j].z * v[j].z + v[j].w * v[j].w); }
    const float rstd = rsqrtf(wave_sum(s) * (1.f / DM) + EPS);
    u32x2* o8 = (u32x2*)orow + lane;
#pragma unroll
    for (int j = 0; j < 4; ++j) { const f32x4 g = ((const f32x4*)gain)[lane + 64 * j]; u32x2 w; w.x = pk2(v[j].x * rstd * g.x, v[j].y * rstd * g.y); w.y = pk2(v[j].z * rstd * g.z, v[j].w * rstd * g.w); o8[64 * j] = w; }
}
__device__ __forceinline__ int win_dst_group(int g) { return g == 0 ? 0 : g == 1 ? 5 : g <= 5 ? g - 1 : g; }

__device__ __forceinline__ void phase_prep0(const Args& a, float* scr, int gw, int NGW, int gtid, int lane) {
    unsigned char* ws = a.ws;
    { float* sm = (float*)(ws + WS_SMALL);
      if (gtid < 2048) { const float l0 = a.in[3][gtid], l1 = a.in[3][2048 + gtid]; const float m = fmaxf(l0, l1); const float e0 = expf(l0 - m), e1 = expf(l1 - m); sm[gtid] = e0 / (e0 + e1); }
      else if (gtid < 4096) { const float lam = a.in[12][gtid - 2048]; sm[gtid] = -8.f * log1pf(expf(-lam)); } }
    constexpr int I_WIN = (DM / 64) * (NIN / 32), I_SQ = (DM / 64) * (DM / 32);
    for (int it = gw; it < I_WIN + 3 * I_SQ; it += NGW) {
        int r = it;
        if (r < I_WIN) { const int nblk = NIN / 32, kb = r / nblk, nb = r % nblk, n0 = nb * 32; transpose_item(a.in[5], DM, NIN, (bf16*)(ws + WS_WINT), kb * 64, n0, win_dst_group(n0 >> 10) * 1024 + (n0 & 1023), scr, lane); continue; }
        r -= I_WIN; const int which = r / I_SQ; r %= I_SQ; const int nblk = DM / 32, kb = r / nblk, nb = r % nblk;
        transpose_item(a.in[14 + which], DM, DM, (bf16*)(ws + (which == 0 ? WS_WAT : which == 1 ? WS_WBT : WS_WOT)), kb * 64, nb * 32, nb * 32, scr, lane);
    }
    bf16* A0 = (bf16*)a.out;
    for (int m = gw; m < MPAD; m += NGW) {
        if (m < MREAL) norm_row_bf16(xrow_ptr(a, m), a.in[4], A0 + (size_t)m * DM, lane);
        else if (m < MREAL + NMETA) norm_row_bf16(a.in[2] + (size_t)(m - MREAL) * DM, a.in[4], A0 + (size_t)m * DM, lane);
        else { u32x4* o = (u32x4*)(A0 + (size_t)m * DM); o[lane] = (u32x4){0u, 0u, 0u, 0u}; o[lane + 64] = (u32x4){0u, 0u, 0u, 0u}; }
    }
}
__device__ __forceinline__ void phase_prep2(const Args& a, int gw, int NGW, int lane) {
    unsigned char* ws = a.ws; bf16* A0 = (bf16*)(ws + WS_A0B); const bf16* of = (const bf16*)a.out; const bf16* ob = (const bf16*)((const unsigned char*)a.out + OUT_OB); float* rstdo = (float*)(ws + WS_RSTDO);
    for (int m = gw; m < MREAL; m += NGW) {
        norm_row_bf16(xrow_ptr(a, m), a.in[4], A0 + (size_t)m * DM, lane);
#ifdef EXP_V1SCAN
        const u32x4* op = (const u32x4*)(of + (size_t)m * 2048 + 1024) + 2 * lane;
        float o[8], p[8], o2[8], p2[8]; unpack8(op[0], o); unpack8(op[1], p); float ss = 0.f;
#pragma unroll
        for (int j = 0; j < 8; ++j) { o2[j] = 0.f; p2[j] = 0.f; }
#else
        const u32x4* op = (const u32x4*)(of + (size_t)m * DM) + 2 * lane; const u32x4* oq = (const u32x4*)(ob + (size_t)m * DM) + 2 * lane;
        float o[8], p[8], o2[8], p2[8]; unpack8(op[0], o); unpack8(op[1], p); unpack8(oq[0], o2); unpack8(oq[1], p2); float ss = 0.f;
#endif
#pragma unroll
        for (int j = 0; j < 8; ++j) { const float x = o[j] + o2[j], y = p[j] + p2[j]; ss += x * x + y * y; }
        ss += __shfl_xor(ss, 1); ss += __shfl_xor(ss, 2); ss += __shfl_xor(ss, 4);
        if ((lane & 7) == 0) rstdo[(size_t)m * 8 + (lane >> 3)] = rsqrtf(ss * (1.f / 128.f) + EPS);
    }
}
__device__ __forceinline__ void phase_prep3(const Args& a, float* scr, int gw, int NGW, int lane) {
    unsigned char* ws = a.ws;
    constexpr int I_1 = (DM / 64) * (DFF / 32), I_2 = (DFF / 64) * (DM / 32);
    for (int it = gw; it < I_1 + I_2; it += NGW) {
        if (it < I_1) { const int nblk = DFF / 32, kb = it / nblk, nb = it % nblk; transpose_item(a.in[18], DM, DFF, (bf16*)(ws + WS_W1T), kb * 64, nb * 32, nb * 32, scr, lane); }
        else { const int r = it - I_1, nblk = DM / 32, kb = r / nblk, nb = r % nblk; transpose_item(a.in[19], DFF, DM, (bf16*)(ws + WS_W2T), kb * 64, nb * 32, nb * 32, scr, lane); }
    }
}
__device__ __forceinline__ void phase_norm1(const Args& a, int gw, int NGW, int lane) {
    unsigned char* ws = a.ws;
    for (int m = gw; m < MREAL; m += NGW) norm_row_bf16((const float*)(ws + WS_X1) + (size_t)m * DM, a.in[17], (bf16*)(ws + WS_A1) + (size_t)m * DM, lane);
}
__device__ __forceinline__ void phase_final(const Args& a, int gw, int NGW, int lane) {
    unsigned char* ws = a.ws;
    for (int m = gw; m < MREAL; m += NGW) {
        const f32x4* xr = (const f32x4*)((const float*)(ws + WS_X1) + (size_t)m * DM) + lane; f32x4 v[4]; float s = 0.f;
#pragma unroll
        for (int j = 0; j < 4; ++j) { v[j] = xr[64 * j]; s += (v[j].x * v[j].x + v[j].y * v[j].y) + (v[j].z * v[j].z + v[j].w * v[j].w); }
        const float rstd = rsqrtf(wave_sum(s) * (1.f / DM) + EPS);
        f32x4* o = (f32x4*)(a.out + (size_t)m * DM) + lane;
#pragma unroll
        for (int j = 0; j < 4; ++j) { const f32x4 g = ((const f32x4*)a.in[20])[lane + 64 * j]; o[64 * j] = v[j] * rstd * g; }
    }
}

__device__ __forceinline__ size_t in_row(int s, int p) { return p < NMETA ? (size_t)(MREAL + p) : (size_t)s * SEQ + (p - NMETA); }
__device__ __forceinline__ float xa_at(const bf16* XA, int s, int p, int C) { return (p < 0 || p >= LTOT) ? 0.f : bf2f(XA[in_row(s, p) * DM + C]); }

template <int DIR> __device__ __forceinline__ void rglru_sweep(const Args& a, float* Was, float* Wxs, float* xcs, int s, int h, int c) {
    const int C = h * 128 + c; unsigned char* ws = a.ws; const bf16* XA = (const bf16*)(ws + WS_XA); bf16* hout = (bf16*)(ws + (DIR == 0 ? WS_HF : WS_HB));
    const float cw0 = a.in[6][C], cw1 = a.in[6][DM + C], cw2 = a.in[6][2 * DM + C], cw3 = a.in[6][3 * DM + C], cb = a.in[7][C];
    for (int i = c; i < 128 * 128; i += 128) { Was[i] = a.in[8][(size_t)(DIR * 8 + h) * 16384 + i]; Wxs[i] = a.in[10][(size_t)(DIR * 8 + h) * 16384 + i]; }
    const float ba = a.in[9][DIR * DM + C], bx = a.in[11][DIR * DM + C], cl = ((const float*)(ws + WS_SMALL))[2048 + DIR * DM + C];
    float hst = 0.f;
    const int ntile = DIR == 0 ? LTOT / 16 : SEQ / 16;
    for (int tl = 0; tl < ntile; ++tl) {
        const int p0 = DIR == 0 ? tl * 16 : LTOT - 16 * (tl + 1);
        float xv[19];
#pragma unroll
        for (int j = 0; j < 19; ++j) xv[j] = xa_at(XA, s, p0 - 2 + j, C);
        float xc[16];
#pragma unroll
        for (int t = 0; t < 16; ++t) xc[t] = cb + cw0 * xv[t] + cw1 * xv[t + 1] + cw2 * xv[t + 2] + cw3 * xv[t + 3];
        __syncthreads();
#pragma unroll
        for (int t = 0; t < 16; ++t) xcs[t * 128 + c] = xc[t];
        __syncthreads();
        float ra[16], rx[16];
#pragma unroll
        for (int t = 0; t < 16; ++t) { ra[t] = ba; rx[t] = bx; }
        for (int i = 0; i < 128; ++i) { const float wa = Was[i * 128 + c], wx = Wxs[i * 128 + c];
#pragma unroll
            for (int t = 0; t < 16; ++t) { const float xi = xcs[t * 128 + i]; ra[t] += xi * wa; rx[t] += xi * wx; } }
#pragma unroll
        for (int k = 0; k < 16; ++k) { const int t = DIR == 0 ? k : 15 - k;
            const float r = 1.f / (1.f + expf(-ra[t])), ig = 1.f / (1.f + expf(-rx[t])); const float la = cl * r; const float av = expf(la), mult = sqrtf(-expm1f(2.f * la));
            hst = av * hst + mult * (ig * xc[t]);
            const int p = p0 + t;
#ifdef EXP_V1SCAN
            if (p >= NMETA) { bf16* dst = (bf16*)a.out + ((size_t)s * SEQ + (p - NMETA)) * 2048 + C; if (DIR == 1) *dst = (bf16)f2bf(hst); else *dst = (bf16)f2bf(bf2f(*dst) + hst); } }
#else
            if (p >= NMETA) hout[((size_t)s * SEQ + (p - NMETA)) * DM + C] = (bf16)f2bf(hst); }
#endif
    }
}
__global__ void __launch_bounds__(128) k_rglru_naive(Args a) {
    extern __shared__ __attribute__((aligned(16))) unsigned char lds[];
    float* Was = (float*)lds; float* Wxs = Was + 16384; float* xcs = Wxs + 16384;
#ifdef EXP_A
    const int s = blockIdx.x / 8, h = blockIdx.x % 8, c = threadIdx.x;
    rglru_sweep<1>(a, Was, Wxs, xcs, s, h, c); __syncthreads(); rglru_sweep<0>(a, Was, Wxs, xcs, s, h, c);
#else
    const int dir = blockIdx.x / 48, s = (blockIdx.x % 48) / 8, h = blockIdx.x % 8, c = threadIdx.x;
    if (dir == 0) rglru_sweep<0>(a, Was, Wxs, xcs, s, h, c); else rglru_sweep<1>(a, Was, Wxs, xcs, s, h, c);
#endif
}

template <int DIR> __device__ __forceinline__ void hgrn_sweep(const Args& a, float (*qs)[128], float (*fs)[128], float (*ks)[128], int s, int hd, int j) {
    const int C = hd * 128 + j; unsigned char* ws = a.ws; bf16* oout = (bf16*)((unsigned char*)a.out + (DIR == 0 ? 0 : OUT_OB));
    const bf16* Q = (const bf16*)(ws + WS_Q); const bf16* G = (const bf16*)(ws + (DIR == 0 ? WS_GF : WS_GB)); const bf16* V = (const bf16*)(ws + WS_V);
    float S[128];
#pragma unroll
    for (int k = 0; k < 128; ++k) S[k] = 0.f;
    const int nsteps = DIR == 0 ? LTOT : SEQ;
    size_t r0 = in_row(s, DIR == 0 ? 0 : LTOT - 1);
    float nq = bf2f(Q[r0 * DM + C]), ng = bf2f(G[r0 * DM + C]), nv = bf2f(V[r0 * DM + C]);
    for (int st = 0; st < nsteps; ++st) {
        const int p = DIR == 0 ? st : LTOT - 1 - st; const int buf = st & 1;
        const float qv = nq, gv = ng, vv = nv;
        if (st + 1 < nsteps) { const size_t rn = in_row(s, DIR == 0 ? p + 1 : p - 1); nq = bf2f(Q[rn * DM + C]); ng = bf2f(G[rn * DM + C]); nv = bf2f(V[rn * DM + C]); }
        qs[buf][j] = qv; fs[buf][j] = expf(gv); ks[buf][j] = -expm1f(gv);
        __syncthreads();
        float o = 0.f;
#pragma unroll
        for (int k = 0; k < 128; ++k) { S[k] = fs[buf][k] * S[k] + ks[buf][k] * vv; o += qs[buf][k] * S[k]; }
#ifdef EXP_V1SCAN
        if (p >= NMETA) { bf16* dst = (bf16*)a.out + ((size_t)s * SEQ + (p - NMETA)) * 2048 + 1024 + C; if (DIR == 1) *dst = (bf16)f2bf(o); else *dst = (bf16)f2bf(bf2f(*dst) + o); }
#else
        if (p >= NMETA) oout[((size_t)s * SEQ + (p - NMETA)) * DM + C] = (bf16)f2bf(o);
#endif
    }
}
__global__ void __launch_bounds__(128) k_hgrn_naive(Args a) {
    __shared__ float qs[2][128], fs[2][128], ks[2][128];
#ifdef EXP_A
    const int s = blockIdx.x / 8, hd = blockIdx.x % 8, j = threadIdx.x;
    hgrn_sweep<1>(a, qs, fs, ks, s, hd, j); __syncthreads(); hgrn_sweep<0>(a, qs, fs, ks, s, hd, j);
#else
    const int dir = blockIdx.x / 48, s = (blockIdx.x % 48) / 8, hd = blockIdx.x % 8, j = threadIdx.x;
    if (dir == 0) hgrn_sweep<0>(a, qs, fs, ks, s, hd, j); else hgrn_sweep<1>(a, qs, fs, ks, s, hd, j);
#endif
}

constexpr int LDS_RING = 131072, LDSCTL_OFF = LDS_RING, LDS_BYTES = 147456;
template <int ONLY> __global__ void __launch_bounds__(512, 2) mega_t(Args a) {
    extern __shared__ __attribute__((aligned(16))) unsigned char lds[];
    PG8_LAS unsigned char* L = (PG8_LAS unsigned char*)lds;
    const int tid = threadIdx.x, lane = tid & 63, wave = __builtin_amdgcn_readfirstlane(tid >> 6);
    const int G = gridDim.x, gw = blockIdx.x * 8 + wave, NGW = G * 8, gtid = blockIdx.x * 512 + tid;
    unsigned char* ws = a.ws; bf16* outb = (bf16*)a.out;
#ifdef EXP_NOPROLOG
    XcdBarrier bar; bar.bar = (unsigned*)(ws + WS_CTL) + CW_BAR; bar.x = 0; bar.st = (volatile LAS unsigned*)(L + LDSCTL_OFF + 64);
#else
    for (int u = tid; u < (LDS_BYTES - LDSCTL_OFF) / 4; u += 512) ((LAS unsigned*)(L + LDSCTL_OFF))[u] = 0u;
    __syncthreads();
    XcdBarrier bar = xcd_barrier_post((unsigned*)(ws + WS_CTL) + CW_BAR + a.li * XCD_BAR_WORDS, (volatile LAS unsigned*)(L + LDSCTL_OFF + 64));
#endif
    const int lo = a.ph_lo, hi = a.ph_hi;
#define IN(k) (ONLY < 0 ? (lo <= (k) && (k) < hi) : (ONLY == (k)))
#define SEAM(k) do { if (ONLY < 0 && (k) + 1 < hi) xcd_barrier(bar); } while (0)
    float* scr = (float*)(lds + wave * 8448);
    constexpr int NOSPLIT = 1 << 30;
    pg8::StaticOrder S;
    if (IN(0)) { phase_prep0(a, scr, gw, NGW, gtid, lane); SEAM(0); }
    if (IN(1)) {
        pg8::Gemm g{outb, (const bf16*)(ws + WS_WINT), MPAD, NIN1, DM, outb, NOSPLIT}; S.init(MPAD, NIN1, G, blockIdx.x);
        pg8::EpiRow8<FP1> E{{(bf16*)(ws + WS_XA), (const float*)(ws + WS_SMALL)}};
        pg8::gemm_phase<pg8::EpiRow8<FP1>, pg8::StaticOrder, true, true>(L, g, S, E); SEAM(1);
    }
#ifndef NAIVE_SCANS
    if (IN(2)) { if (blockIdx.x < 96) phase_hgrn(a, L, blockIdx.x, tid); SEAM(2); }
    if (IN(3)) { if (blockIdx.x < 96) phase_rglru(a, L, blockIdx.x, tid); SEAM(3); }
#endif
    if (IN(4)) { phase_prep2(a, gw, NGW, lane); SEAM(4); }
    if (IN(5)) {
        pg8::Gemm g{(const bf16*)(ws + WS_A0B), (const bf16*)(ws + WS_WINT) + (size_t)NIN1 * DM, MREAL, 2048, DM, (const bf16*)(ws + WS_A0B), NOSPLIT}; S.init(MREAL, 2048, G, blockIdx.x);
        pg8::EpiRow8<FP5a> E{{(const bf16*)(ws + WS_HF), (const bf16*)(ws + WS_HB), outb, (const bf16*)((unsigned char*)a.out + OUT_OB), (const float*)(ws + WS_RSTDO), a.in[13], (bf16*)(ws + WS_BRA), (bf16*)(ws + WS_BRB)}};
        pg8::gemm_phase<pg8::EpiRow8<FP5a>, pg8::StaticOrder, true, true>(L, g, S, E); SEAM(5);
    }
    if (IN(6)) {
        pg8::Gemm g{(const bf16*)(ws + WS_A0B), (const bf16*)(ws + WS_WINT) + (size_t)(NIN1 + 2048) * DM, MREAL, 2048, DM, (const bf16*)(ws + WS_A0B), NOSPLIT}; S.init(MREAL, 2048, G, blockIdx.x);
        pg8::EpiRow8<FP5b> E{{(bf16*)(ws + WS_SGA), (bf16*)(ws + WS_SGB), a.in[13]}};
        pg8::gemm_phase<pg8::EpiRow8<FP5b>, pg8::StaticOrder, true, true>(L, g, S, E); SEAM(6);
    }
    if (IN(7)) {
        pg8::Gemm g{(const bf16*)(ws + WS_BRA), (const bf16*)(ws + WS_WAT), MREAL, DM, DM, (const bf16*)(ws + WS_BRA), NOSPLIT}; S.init(MREAL, DM, G, blockIdx.x);
        pg8::EpiRow8<FP3b1> E{{(const bf16*)(ws + WS_SGA), outb}};
        pg8::gemm_phase<pg8::EpiRow8<FP3b1>, pg8::StaticOrder, true, true>(L, g, S, E);
#ifndef EXP_X2
        __syncthreads(); phase_prep3(a, scr, gw, NGW, lane);
#endif
        SEAM(7);
    }
    if (IN(8)) {
        pg8::Gemm g{(const bf16*)(ws + WS_BRB), (const bf16*)(ws + WS_WBT), MREAL, DM, DM, (const bf16*)(ws + WS_BRB), NOSPLIT}; S.init(MREAL, DM, G, blockIdx.x);
        pg8::EpiRow8<FP3b2> E{{(const bf16*)(ws + WS_SGB), outb}};
        pg8::gemm_phase<pg8::EpiRow8<FP3b2>, pg8::StaticOrder, true, true>(L, g, S, E); SEAM(8);
    }
    if (IN(9)) {
        pg8::Gemm g{outb, (const bf16*)(ws + WS_WOT), MREAL, DM, DM, outb, NOSPLIT}; S.init(MREAL, DM, G, blockIdx.x);
        pg8::EpiRow8<FP3c> E{{a.in[0], a.in[1], (float*)(ws + WS_X1)}};
        pg8::gemm_phase<pg8::EpiRow8<FP3c>, pg8::StaticOrder, true, true>(L, g, S, E); SEAM(9);
    }
    if (IN(10)) { phase_norm1(a, gw, NGW, lane); SEAM(10); }
    if (IN(11)) {
        pg8::Gemm g{(const bf16*)(ws + WS_A1), (const bf16*)(ws + WS_W1T), MREAL, DFF, DM, (const bf16*)(ws + WS_A1), NOSPLIT}; S.init(MREAL, DFF, G, blockIdx.x);
        pg8::EpiRow8<FP4> E{{outb, (bf16*)(ws + WS_HHI)}};
        pg8::gemm_phase<pg8::EpiRow8<FP4>, pg8::StaticOrder, true, true>(L, g, S, E); SEAM(11);
    }
    if (IN(12)) {
        pg8::Gemm g{outb, (const bf16*)(ws + WS_W2T), MREAL, DM, DFF, (const bf16*)(ws + WS_HHI), HSPLIT_PM}; S.init(MREAL, DM, G, blockIdx.x);
        pg8::EpiRow8<FP5> E{{(float*)(ws + WS_X1)}};
        pg8::gemm_phase<pg8::EpiRow8<FP5>, pg8::StaticOrder, true, true>(L, g, S, E); SEAM(12);
    }
    if (IN(13)) { phase_final(a, gw, NGW, lane); }
#ifdef EXP_X2
    if (ONLY == 14) { phase_prep3(a, scr, gw, NGW, lane); }
#endif
#undef IN
#undef SEAM
}


#ifdef EXP_CKSUM
constexpr size_t WS_DIAG = 22 * MiB + 512 * 1024;
__global__ void __launch_bounds__(256) k_cksum(const unsigned* p, size_t nwords, unsigned long long* slot) {
    unsigned long long acc = 0;
    for (size_t i = (size_t)blockIdx.x * 256 + threadIdx.x; i < nwords; i += (size_t)gridDim.x * 256) { const unsigned w = p[i]; acc += (unsigned long long)w * (unsigned long long)((i & 1023) * 2 + 1); }
    for (int o = 1; o < 64; o <<= 1) acc += __shfl_xor(acc, o);
    if ((threadIdx.x & 63) == 0) atomicAdd(slot, acc);
}
__global__ void k_ckinit(unsigned long long* d) { if (threadIdx.x == 0 && blockIdx.x == 0 && d[64] != 0x1234567855aa33ccull) { for (int k = 0; k < 66; ++k) d[k] = 0; } }
__global__ void k_cmp(unsigned long long* d) {
    if (threadIdx.x || blockIdx.x) return;
    const unsigned long long MAGIC = 0x1234567855aa33ccull;
    if (d[64] == MAGIC) { if (d[65] == 0) { for (int k = 1; k < 32; ++k) if (d[k] != d[32 + k]) { d[65] = (unsigned long long)k; break; } } }
    else { d[65] = 0; }
    for (int k = 0; k < 32; ++k) { d[32 + k] = d[k]; d[k] = 0; }
    d[64] = MAGIC;
}
__global__ void __launch_bounds__(256) k_scale(float* y, size_t n, const unsigned long long* d) {
    const float sc = 1.f + 0.1f * (float)d[65];
    if (d[65] == 0) return;
    for (size_t i = (size_t)blockIdx.x * 256 + threadIdx.x; i < n; i += (size_t)gridDim.x * 256) y[i] *= sc;
}
#define CK(k, ptr, bytes) hipLaunchKernelGGL(k_cksum, dim3(1024), dim3(256), 0, stream, (const unsigned*)(ptr), (size_t)(bytes) / 4, (unsigned long long*)((char*)d_ws + WS_DIAG) + (k))
#else
#define CK(k, ptr, bytes) do {} while (0)
#endif
#ifdef EXP_FLUSH
__global__ void __launch_bounds__(256) k_flush(Args a) {
    const size_t n = (size_t)MREAL * DM / 4; const f32x4* p0 = (const f32x4*)a.in[0]; const f32x4* p1 = (const f32x4*)a.in[1];
    f32x4 acc = {0.f, 0.f, 0.f, 0.f};
    for (size_t i = (size_t)blockIdx.x * 256 + threadIdx.x; i < n; i += (size_t)gridDim.x * 256) { const f32x4 v = i < (size_t)NPROMPT_ROWS * DM / 4 ? p0[i] : p1[i - (size_t)NPROMPT_ROWS * DM / 4]; acc += v; }
    if (acc.x + acc.y + acc.z + acc.w == 1.2345e30f) ((float*)(a.ws + WS_SMALL))[8191] = 1.f;
}
#define FLUSH() hipLaunchKernelGGL(k_flush, dim3(2048), dim3(256), 0, stream, a)
#else
#define FLUSH() do {} while (0)
#endif
#ifdef EXP_A
#define NAIVE_WGS 48
#else
#define NAIVE_WGS 96
#endif
#define mega mega_t<-1>
extern "C" void kernel_launch(void* const* d_in, const int* in_sizes, int n_in, void* d_out, int out_size, void* d_ws, size_t ws_size, hipStream_t stream) {
    static int grid = 0;
    constexpr int RG_LDS = (2 * 16384 + 16 * 128) * 4;
    if (grid == 0) {
        if (n_in != 21 || out_size != MREAL * DM || ws_size < WS_END) { fprintf(stderr, "kernel_launch: unexpected shapes (n_in %d, out %d, ws %zu)\n", n_in, out_size, ws_size); grid = -1; return; }
        int dev = 0, cus = 0, per_cu = 0;
        if (hipGetDevice(&dev) != hipSuccess || hipDeviceGetAttribute(&cus, hipDeviceAttributeMultiprocessorCount, dev) != hipSuccess) { grid = -1; return; }
        #ifdef EXP_TEMPL
#define SA(k) (void)hipFuncSetAttribute((const void*)mega_t<k>, hipFuncAttributeMaxDynamicSharedMemorySize, LDS_BYTES);
        SA(14) SA(0) SA(1) SA(4) SA(5) SA(6) SA(7) SA(8) SA(9) SA(10) SA(11) SA(12) SA(13)
#undef SA
#endif
        if (hipFuncSetAttribute((const void*)mega, hipFuncAttributeMaxDynamicSharedMemorySize, LDS_BYTES) != hipSuccess || hipFuncSetAttribute((const void*)k_rglru_naive, hipFuncAttributeMaxDynamicSharedMemorySize, RG_LDS) != hipSuccess) { fprintf(stderr, "kernel_launch: hipFuncSetAttribute failed\n"); grid = -1; return; }
        if (hipOccupancyMaxActiveBlocksPerMultiprocessor(&per_cu, (const void*)mega, 512, LDS_BYTES) != hipSuccess || per_cu < 1) { fprintf(stderr, "kernel_launch: occupancy query says %d workgroups per CU\n", per_cu); (void)hipGetLastError(); grid = -1; return; }
        grid = cus;
    }
    if (grid < 0) return;
#ifdef DIAG_POISON
    (void)hipMemsetAsync((char*)d_ws, 0xAA, WS_END, stream); (void)hipMemsetAsync((char*)d_out, 0xAA, (size_t)MREAL * DM * 4, stream);
#endif
    (void)hipMemsetAsync((char*)d_ws + WS_CTL, 0, CTL_BYTES, stream);
    Args a{};
    for (int i = 0; i < 21; ++i) a.in[i] = (const float*)d_in[i];
    a.out = (float*)d_out; a.ws = (unsigned char*)d_ws;
#if !defined(ONE_PER_PHASE) && !defined(NAIVE_SCANS)
    a.ph_lo = 0; a.ph_hi = 14; a.li = 0;
    hipLaunchKernelGGL(mega, dim3(grid), dim3(512), LDS_BYTES, stream, a);
#elif !defined(ONE_PER_PHASE)
    a.ph_lo = 0; a.ph_hi = 2; a.li = 0;
    hipLaunchKernelGGL(mega, dim3(grid), dim3(512), LDS_BYTES, stream, a);
    hipLaunchKernelGGL(k_hgrn_naive, dim3(NAIVE_WGS), dim3(128), 0, stream, a);
    hipLaunchKernelGGL(k_rglru_naive, dim3(NAIVE_WGS), dim3(128), RG_LDS, stream, a);
    a.ph_lo = 4; a.ph_hi = 14; a.li = 1;
    hipLaunchKernelGGL(mega, dim3(grid), dim3(512), LDS_BYTES, stream, a);
#else
#ifdef EXP_CKSUM
    hipLaunchKernelGGL(k_ckinit, dim3(1), dim3(64), 0, stream, (unsigned long long*)((char*)d_ws + WS_DIAG));
#endif
#ifdef EXP_TWICE
    for (int rep = 0; rep < 2; ++rep)
#endif
    for (int ph = 0; ph < 14; ++ph) {
#ifdef EXP_X2
        if (ph == 3) { hipLaunchKernelGGL(k_hgrn_naive, dim3(NAIVE_WGS), dim3(128), 0, stream, a); FLUSH(); continue; }
        if (ph == 2) { hipLaunchKernelGGL(k_rglru_naive, dim3(NAIVE_WGS), dim3(128), RG_LDS, stream, a); FLUSH(); continue; }
        if (ph == 7) { hipLaunchKernelGGL(mega_t<14>, dim3(grid), dim3(512), LDS_BYTES, stream, a); }
#else
        if (ph == 2) { hipLaunchKernelGGL(k_hgrn_naive, dim3(NAIVE_WGS), dim3(128), 0, stream, a); FLUSH(); CK(3, d_out, 2 * UR); continue; }
        if (ph == 3) { hipLaunchKernelGGL(k_rglru_naive, dim3(NAIVE_WGS), dim3(128), RG_LDS, stream, a); FLUSH(); CK(4, (char*)d_ws + WS_HF, UR); CK(4, (char*)d_ws + WS_HB, UR); continue; }
#endif
        a.ph_lo = ph; a.ph_hi = ph + 1; a.li = 0;
#ifdef EXP_CKSUM
        if (ph == 0) {   }
#endif
#ifdef EXP_TEMPL
#define LP(k) case k: hipLaunchKernelGGL(mega_t<k>, dim3(grid), dim3(512), LDS_BYTES, stream, a); break;
        switch (ph) { LP(0) LP(1) LP(4) LP(5) LP(6) LP(7) LP(8) LP(9) LP(10) LP(11) LP(12) LP(13) }
#undef LP
#else
        hipLaunchKernelGGL(mega, dim3(grid), dim3(512), LDS_BYTES, stream, a); FLUSH();
#endif
#ifdef EXP_CKSUM
        { char* w = (char*)d_ws; char* o = (char*)d_out;
          switch (ph) {
            case 0: CK(1, w + WS_WINT, 18 * MiB); CK(1, o, UP); CK(1, w + WS_SMALL, 16384); CK(1, w + WS_WAT, 6 * MiB); break;
            case 1: CK(2, w + WS_XA, 5 * UP); break;
            case 4: CK(5, w + WS_A0B, UR); CK(5, w + WS_RSTDO, (size_t)MREAL * 32); break;
            case 5: CK(6, w + WS_BRA, UR); CK(6, w + WS_BRB, UR); break;
            case 6: CK(7, w + WS_SGA, UR); CK(7, w + WS_SGB, UR); break;
            case 7: CK(8, o, UR); CK(8, w + WS_W1T, 16 * MiB); break;
            case 8: CK(9, o, UR); break;
            case 9: CK(10, w + WS_X1, 2 * UR); break;
            case 10: CK(11, w + WS_A1, UR); break;
            case 11: CK(12, o, 2 * UR); CK(12, w + WS_HHI, 2 * UR); break;
            case 12: CK(13, w + WS_X1, 2 * UR); break;
            default: break; } }
#endif
    }
#ifdef EXP_CKSUM
    hipLaunchKernelGGL(k_cmp, dim3(1), dim3(64), 0, stream, (unsigned long long*)((char*)d_ws + WS_DIAG));
    hipLaunchKernelGGL(k_scale, dim3(2048), dim3(256), 0, stream, (float*)d_out, (size_t)MREAL * DM, (const unsigned long long*)((char*)d_ws + WS_DIAG));
#endif
#endif
}
```

```cpp
#include <hip/hip_runtime.h>
#include <cstdio>
#include <cstdint>
namespace pg8 {
#define PG8_LAS __attribute__((address_space(3)))
typedef unsigned short bf16_t;
typedef short bf16x8 __attribute__((ext_vector_type(8)));
typedef float f32x4 __attribute__((ext_vector_type(4)));
typedef unsigned u32x4 __attribute__((ext_vector_type(4)));
constexpr int BM = 256, BK = 64, HALF = 128, HTB = HALF * BK * 2  , STAGE_BYTES = 8 * HTB, NXCD = 8, WGM = 8;

__host__ __device__ __forceinline__ int lds_byte(int r, int c) { const int st = (r >> 4) * 2 + (c >> 5), rr = r & 15, cc = c & 31, ob = rr * 64 + cc * 2; return st * 1024 + (ob ^ (((ob >> 9) & 1) << 5)); }
__host__ __device__ __forceinline__ void stage_rc(int b, int& R, int& C) { const int st = b / 1024, sb = b % 1024, swz = sb ^ (((sb >> 9) & 1) << 5); R = (st >> 1) * 16 + swz / 64; C = (st & 1) * 32 + (swz % 64) / 2; }
__host__ __device__ __forceinline__ int perm32(int rho) { const int n = rho >> 4, i = rho & 15; return 8 * (i >> 2) + 4 * n + (i & 3); }

struct Unit { int pm, pn; };
struct Gemm { const bf16_t* A; const bf16_t* Bt; int M, N, K; const bf16_t* A2; int pm_split; };

struct StaticOrder {
    int nM, nN, nwg, G, c;
    __host__ __device__ void init(int M, int N, int G_, int c_) { nM = M / BM; nN = N / BM; nwg = nM * nN; G = G_; c = c_; }
    __host__ __device__ bool next(int i, Unit& u) const {
        const long L = (long)i * G + c; if (L >= nwg) return false;
        int wgid = (int)L; { const int q = nwg / NXCD, r = nwg % NXCD, xcd = wgid % NXCD, off = wgid / NXCD; wgid = (xcd < r ? xcd * (q + 1) : r * (q + 1) + (xcd - r) * q) + off; }
        const int nig = WGM * nN, gid = wgid / nig, fm = gid * WGM, gsz = (nM - fm) < WGM ? (nM - fm) : WGM;
        u.pm = fm + ((wgid % nig) % gsz); u.pn = (wgid % nig) / gsz; return true;
    }
    __device__ __forceinline__ void a_ready(const Unit&) const {}
    __device__ __forceinline__ void done(const Unit&) const {}
};

typedef float f32x2v __attribute__((ext_vector_type(2)));
typedef __bf16 bf16x2v __attribute__((ext_vector_type(2)));
__device__ __forceinline__ unsigned cvt_pk_bf16(float lo, float hi) { const f32x2v f = {lo, hi}; const bf16x2v b = __builtin_convertvector(f, bf16x2v); return __builtin_bit_cast(unsigned, b); }
typedef float f32x2 __attribute__((ext_vector_type(2)));
template <class F> struct EpiRow8 {
    static constexpr bool PERM = true, AFTER_DRAIN = false; F f;
    __device__ __forceinline__ void operator()(const f32x4 (&acc)[2][2][4][2], const Unit& u, int wr, int wc, int fr, int fq) const {
        const int row0 = u.pm * BM + wr * 64 + fr, col0 = u.pn * BM + wc * 32 + 8 * fq;
#pragma unroll
        for (int ai = 0; ai < 2; ++ai)
#pragma unroll
            for (int m = 0; m < 4; ++m) {
#pragma unroll
                for (int bj = 0; bj < 2; ++bj) f(row0 + ai * HALF + m * 16, col0 + bj * HALF, acc[ai][bj][m][0], acc[ai][bj][m][1]);
                if (m & 1) asm volatile("" ::: "memory"); }
    }
};
#define PG8_ABASE(pm) ((pm) < g.pm_split ? (const char*)g.A + (size_t)(pm) * tstep : (const char*)g.A2 + (size_t)((pm) - g.pm_split) * tstep)
template <class Epi, class Sched, bool ALIGN_EPI = false, bool SP2 = false>
__device__ __forceinline__ void gemm_phase(PG8_LAS unsigned char* lds, const Gemm g, const Sched& S, const Epi& E) {
    const int tid = threadIdx.x, wid = __builtin_amdgcn_readfirstlane(tid >> 6), lane = tid & 63, wr = wid >> 2, wc = wid & 3, fr = lane & 15, fq = lane >> 4;
    const int K = g.K, nt = K / BK;
    unsigned voffA[2], voffB[2];
#pragma unroll
    for (int i = 0; i < 2; ++i) { int R, C; stage_rc(tid * 16 + i * 8192, R, C); const int Rb = Epi::PERM ? ((R & ~31) + perm32(R & 31)) : R;
        voffA[i] = (unsigned)(R * K + C) * 2u; voffB[i] = (unsigned)(Rb * K + C) * 2u; }
    const size_t kstep = (size_t)(BK * 2);
    const size_t hstep = (size_t)HALF * K * 2;
    const size_t tstep = 2 * hstep;
    const unsigned ldsw = (unsigned)wid * 1024u;
    const int aoff = lds_byte(wr * 64 + fr, fq * 8), boff = lds_byte(wc * 32 + fr, fq * 8);
#define PG8_SA(b, h) (((b) * 2 + (h)) * HTB)
#define PG8_SB(b, h) ((4 + (b) * 2 + (h)) * HTB)
#define PG8_STAGE(bufoff, gbase, voff) do { _Pragma("unroll") for (int _i = 0; _i < 2; ++_i) \
        __builtin_amdgcn_global_load_lds((const unsigned*)((const char*)(gbase) + (voff)[_i]), (PG8_LAS unsigned*)(lds + (bufoff) + ldsw + _i * 8192), 16, 0, 0); } while (0)
#define PG8_LDA(dst, b, h) do { _Pragma("unroll") for (int m = 0; m < 4; ++m) _Pragma("unroll") for (int k = 0; k < 2; ++k) dst[m][k] = *(const PG8_LAS bf16x8*)(lds + PG8_SA(b, h) + aoff + m * 2048 + k * 1024); } while (0)
#define PG8_LDB(dst, b, h) do { _Pragma("unroll") for (int n = 0; n < 2; ++n) _Pragma("unroll") for (int k = 0; k < 2; ++k) dst[n][k] = *(const PG8_LAS bf16x8*)(lds + PG8_SB(b, h) + boff + n * 2048 + k * 1024); } while (0)
#define PG8_MMA(ai, bj, At, Bt) do { __builtin_amdgcn_s_setprio(1); _Pragma("unroll") for (int m = 0; m < 4; ++m) _Pragma("unroll") for (int n = 0; n < 2; ++n) _Pragma("unroll") for (int k = 0; k < 2; ++k) \
        acc[ai][bj][m][n] = __builtin_amdgcn_mfma_f32_16x16x32_bf16(Bt[n][k], At[m][k], acc[ai][bj][m][n], 0, 0, 0); __builtin_amdgcn_s_setprio(0); } while (0)
#define PG8_WAIT_V(n) asm volatile("s_waitcnt vmcnt(" #n ")" ::: "memory")
#define PG8_WAIT_L(n) asm volatile("s_waitcnt lgkmcnt(" #n ")" ::: "memory")
#define PG8_BAR __builtin_amdgcn_s_barrier()
#define PG8_SCHED __builtin_amdgcn_sched_barrier(0)
    Unit cur, nxt; int ui = 0;
    if (!S.next(0, cur)) return;
    f32x4 acc[2][2][4][2];
#pragma unroll
    for (int a = 0; a < 2; ++a)
#pragma unroll
        for (int b = 0; b < 2; ++b)
#pragma unroll
            for (int m = 0; m < 4; ++m)
#pragma unroll
                for (int n = 0; n < 2; ++n) acc[a][b][m][n] = (f32x4){0.f, 0.f, 0.f, 0.f};
    bf16x8 At[4][2], B0[2][2], B1[2][2];
    const char* cA = PG8_ABASE(cur.pm); const char* cB = (const char*)g.Bt + (size_t)cur.pn * tstep;
    S.a_ready(cur);
    if constexpr (SP2) {
        PG8_STAGE(PG8_SB(0, 0), cB, voffB); PG8_STAGE(PG8_SB(0, 1), cB + hstep, voffB); PG8_STAGE(PG8_SA(0, 0), cA, voffA); PG8_STAGE(PG8_SA(0, 1), cA + hstep, voffA);
        if (wr == 1) PG8_BAR;
        PG8_WAIT_V(2); PG8_BAR;
        PG8_STAGE(PG8_SB(1, 0), cB + kstep, voffB); PG8_STAGE(PG8_SA(1, 0), cA + kstep, voffA); PG8_STAGE(PG8_SB(1, 1), cB + hstep + kstep, voffB);
        PG8_WAIT_V(6); PG8_BAR;
    } else {
        PG8_STAGE(PG8_SB(0, 0), cB, voffB); PG8_STAGE(PG8_SA(0, 0), cA, voffA); PG8_STAGE(PG8_SB(0, 1), cB + hstep, voffB); PG8_STAGE(PG8_SA(0, 1), cA + hstep, voffA);
        if (wr == 1) PG8_BAR;
        PG8_WAIT_V(4); PG8_BAR;
        PG8_STAGE(PG8_SB(1, 0), cB + kstep, voffB); PG8_STAGE(PG8_SA(1, 0), cA + kstep, voffA); PG8_STAGE(PG8_SB(1, 1), cB + hstep + kstep, voffB);
        PG8_WAIT_V(6); PG8_BAR;
    }
    for (;;) {
        const bool has_next = S.next(ui + 1, nxt);
        const char* nA = has_next ? PG8_ABASE(nxt.pm) : cA; const char* nB = has_next ? (const char*)g.Bt + (size_t)nxt.pn * tstep : cB;
        for (int t = 0; t < nt; t += 2) {
            const bool last = (t == nt - 2);
            const char* a1 = cA + (size_t)(t + 1) * kstep;
            const char* a2 = last ? nA : cA + (size_t)(t + 2) * kstep; const char* b2 = last ? nB : cB + (size_t)(t + 2) * kstep;
            const char* a3 = a2 + kstep; const char* b3 = b2 + kstep;
            if (last && has_next) S.a_ready(nxt);
            if constexpr (SP2) {
            PG8_LDB(B0, 0, 0); PG8_LDB(B1, 0, 1); PG8_SCHED; PG8_LDA(At, 0, 0); PG8_STAGE(PG8_SA(1, 1), a1 + hstep, voffA);
            PG8_WAIT_V(8); PG8_WAIT_L(0); PG8_BAR; PG8_MMA(0, 0, At, B0); PG8_MMA(0, 1, At, B1); PG8_BAR; PG8_SCHED;
            PG8_LDA(At, 0, 1); PG8_STAGE(PG8_SB(0, 0), b2, voffB); PG8_STAGE(PG8_SB(0, 1), b2 + hstep, voffB); PG8_STAGE(PG8_SA(0, 0), a2, voffA);
            PG8_WAIT_V(8); PG8_WAIT_L(0); PG8_BAR; PG8_MMA(1, 0, At, B0); PG8_MMA(1, 1, At, B1); PG8_BAR; PG8_SCHED;
            PG8_LDB(B0, 1, 0); PG8_LDB(B1, 1, 1); PG8_SCHED; PG8_LDA(At, 1, 0); PG8_STAGE(PG8_SA(0, 1), a2 + hstep, voffA);
            PG8_WAIT_V(8); PG8_WAIT_L(0); PG8_BAR; PG8_MMA(0, 0, At, B0); PG8_MMA(0, 1, At, B1); PG8_BAR; PG8_SCHED;
            PG8_LDA(At, 1, 1); PG8_STAGE(PG8_SB(1, 0), b3, voffB); PG8_STAGE(PG8_SB(1, 1), b3 + hstep, voffB); PG8_STAGE(PG8_SA(1, 0), a3, voffA);
            PG8_WAIT_V(8); PG8_WAIT_L(0); PG8_BAR; PG8_MMA(1, 0, At, B0); PG8_MMA(1, 1, At, B1); PG8_BAR; PG8_SCHED;
            } else {
            PG8_LDB(B0, 0, 0); PG8_SCHED; PG8_LDA(At, 0, 0); PG8_STAGE(PG8_SA(1, 1), a1 + hstep, voffA);
            PG8_WAIT_L(8); PG8_BAR; PG8_WAIT_L(0); PG8_MMA(0, 0, At, B0); PG8_BAR; PG8_SCHED;
            PG8_LDB(B1, 0, 1); PG8_STAGE(PG8_SB(0, 0), b2, voffB);
            PG8_BAR; PG8_WAIT_L(0); PG8_MMA(0, 1, At, B1); PG8_BAR;
            PG8_LDA(At, 0, 1); PG8_STAGE(PG8_SA(0, 0), a2, voffA);
            PG8_BAR; PG8_WAIT_L(0); PG8_MMA(1, 0, At, B0); PG8_BAR; PG8_SCHED;
            PG8_STAGE(PG8_SB(0, 1), b2 + hstep, voffB);
            PG8_WAIT_V(6); PG8_BAR; PG8_MMA(1, 1, At, B1); PG8_BAR;
            PG8_LDB(B0, 1, 0); PG8_SCHED; PG8_LDA(At, 1, 0); PG8_STAGE(PG8_SA(0, 1), a2 + hstep, voffA);
            PG8_WAIT_L(8); PG8_BAR; PG8_WAIT_L(0); PG8_MMA(0, 0, At, B0); PG8_BAR; PG8_SCHED;
            PG8_LDB(B1, 1, 1); PG8_STAGE(PG8_SB(1, 0), b3, voffB);
            PG8_BAR; PG8_WAIT_L(0); PG8_MMA(0, 1, At, B1); PG8_BAR;
            PG8_LDA(At, 1, 1); PG8_STAGE(PG8_SA(1, 0), a3, voffA);
            PG8_BAR; PG8_WAIT_L(0); PG8_MMA(1, 0, At, B0); PG8_BAR; PG8_SCHED;
            PG8_STAGE(PG8_SB(1, 1), b3 + hstep, voffB);
            PG8_WAIT_V(6); PG8_BAR; PG8_MMA(1, 1, At, B1); PG8_BAR;
            }
        }
        if constexpr (ALIGN_EPI) { if (wr == 0) PG8_BAR; }
        if constexpr (!Epi::AFTER_DRAIN) { E(acc, cur, wr, wc, fr, fq); S.done(cur); }
        if (!has_next) break;
#pragma unroll
        for (int a = 0; a < 2; ++a)
#pragma unroll
            for (int b = 0; b < 2; ++b)
#pragma unroll
                for (int m = 0; m < 4; ++m)
#pragma unroll
                    for (int n = 0; n < 2; ++n) acc[a][b][m][n] = (f32x4){0.f, 0.f, 0.f, 0.f};
        cur = nxt; cA = nA; cB = nB; ++ui;
        if constexpr (ALIGN_EPI) { if (wr == 1) PG8_BAR; }
    }
    PG8_WAIT_V(0);
    if constexpr (!ALIGN_EPI) { if (wr == 0) PG8_BAR; }
    PG8_BAR;
    if constexpr (Epi::AFTER_DRAIN) { E.fused(acc, cur, wr, wc, fr, fq, lds, wid, lane); S.done(cur); }
#undef PG8_SA
#undef PG8_SB
#undef PG8_STAGE
#undef PG8_LDA
#undef PG8_LDB
#undef PG8_MMA
#undef PG8_WAIT_V
#undef PG8_WAIT_L
#undef PG8_BAR
#undef PG8_SCHED
}
}

constexpr int DM = 1024, NSEQ = 6, SEQ = 8192, NMETA = 16, LTOT = SEQ + NMETA;
constexpr int MREAL = NSEQ * SEQ;
constexpr int MPAD = MREAL + 256;
constexpr int NPROMPT_ROWS = 2 * SEQ;
constexpr int NIN = 9216, NIN1 = 5120, DFF = 4096;
constexpr float EPS = 1e-6f;
constexpr size_t MiB = 1u << 20;
constexpr size_t UP = (size_t)MPAD * DM * 2;
constexpr size_t UR = (size_t)MREAL * DM * 2;
constexpr size_t WS_CTL = 0, CTL_BYTES = 1 * MiB;
constexpr size_t WS_WINT = 1 * MiB;
constexpr size_t WS_W1T = 1 * MiB, WS_W2T = 9 * MiB;
constexpr size_t WS_SMALL = 20 * MiB;
constexpr size_t WS_RSTDO = 21 * MiB;
constexpr size_t WS_WAT = 23 * MiB, WS_WBT = 25 * MiB, WS_WOT = 27 * MiB;
constexpr size_t WS_R0 = 29 * MiB;
constexpr size_t WS_XA = WS_R0, WS_Q = WS_R0 + UP, WS_GF = WS_R0 + 2 * UP, WS_GB = WS_R0 + 3 * UP, WS_V = WS_R0 + 4 * UP;
constexpr size_t WS_OF = WS_GF, WS_OB = WS_GB;
constexpr size_t WS_A0B = WS_XA;
constexpr size_t WS_BRA = WS_Q, WS_BRB = WS_V;
constexpr size_t WS_T1 = WS_GF;
constexpr size_t WS_X1 = WS_R0, WS_A1 = WS_R0 + 2 * UR, WS_HHI = WS_R0 + 3 * UR;
constexpr size_t WS_END = WS_R0 + 5 * UP;
static_assert(WS_END <= 512 * MiB, "workspace map");
constexpr int HSPLIT_PM = MREAL / 256 / 2;
constexpr size_t OUT_OB = UR;
constexpr int CW_BAR = 4096;

typedef unsigned short bf16;
typedef float f32x4 __attribute__((ext_vector_type(4)));
typedef unsigned u32x4 __attribute__((ext_vector_type(4)));
typedef unsigned u32x2 __attribute__((ext_vector_type(2)));
#define LAS __attribute__((address_space(3)))

struct Args { const float* in[21]; float* out; unsigned char* ws; int ph_lo, ph_hi, li, pad; };

__device__ __forceinline__ float bf2f(unsigned v) { return __uint_as_float(v << 16); }
__device__ __forceinline__ unsigned f2bf(float f) { unsigned u = __float_as_uint(f); return (u + 0x7fffu + ((u >> 16) & 1u)) >> 16; }
__device__ __forceinline__ unsigned pk2(float lo, float hi) { return f2bf(lo) | (f2bf(hi) << 16); }
__device__ __forceinline__ float fsigmoid(float x) { return __builtin_amdgcn_rcpf(1.f + __expf(-x)); }
__device__ __forceinline__ float wave_sum(float v) {
#pragma unroll
    for (int o = 1; o < 64; o <<= 1) v += __shfl_xor(v, o);
    return v;
}
__device__ __forceinline__ void unpack8(u32x4 w, float (&o)[8]) {
    o[0] = __uint_as_float(w.x << 16); o[1] = __uint_as_float(w.x & 0xffff0000u); o[2] = __uint_as_float(w.y << 16); o[3] = __uint_as_float(w.y & 0xffff0000u);
    o[4] = __uint_as_float(w.z << 16); o[5] = __uint_as_float(w.z & 0xffff0000u); o[6] = __uint_as_float(w.w << 16); o[7] = __uint_as_float(w.w & 0xffff0000u);
}
__device__ __forceinline__ u32x4 pack8(const float (&v)[8]) {
    u32x4 w; w.x = pg8::cvt_pk_bf16(v[0], v[1]); w.y = pg8::cvt_pk_bf16(v[2], v[3]); w.z = pg8::cvt_pk_bf16(v[4], v[5]); w.w = pg8::cvt_pk_bf16(v[6], v[7]); return w;
}
__device__ __forceinline__ const float* xrow_ptr(const Args& a, int r) { return r < NPROMPT_ROWS ? a.in[0] + (size_t)r * DM : a.in[1] + (size_t)(r - NPROMPT_ROWS) * DM; }

struct FP1 { bf16* base; const float* lb;
    __device__ __forceinline__ void operator()(int row, int col, f32x4 v0, f32x4 v1) const {
        const int cg = col >> 10, c = col & 1023;
        float v[8] = {v0[0], v0[1], v0[2], v0[3], v1[0], v1[1], v1[2], v1[3]};
        if (cg == 1) {
#pragma unroll
            for (int j = 0; j < 8; ++j) v[j] = v[j] * fsigmoid(v[j]);
        } else if (cg == 2 || cg == 3) {
            const float* l = lb + (cg - 2) * DM + c; const f32x4 l0 = *(const f32x4*)l, l1 = *(const f32x4*)(l + 4);
            const float lv[8] = {l0[0], l0[1], l0[2], l0[3], l1[0], l1[1], l1[2], l1[3]};
#pragma unroll
            for (int j = 0; j < 8; ++j) v[j] = __logf(lv[j] + (1.f - lv[j]) * fsigmoid(v[j]));
        }
        *(u32x4*)(base + (size_t)cg * (UP / 2) + (size_t)row * DM + c) = pack8(v);
    }
};
struct FP5a { const bf16* hf; const bf16* hb; const bf16* of; const bf16* ob; const float* rstdo; const float* hgg; bf16* bra; bf16* brb;
    __device__ __forceinline__ void operator()(int row, int col, f32x4 v0, f32x4 v1) const {
        const int cg = col >> 10, c = col & 1023; const size_t off = (size_t)row * DM + c;
        float v[8] = {v0[0], v0[1], v0[2], v0[3], v1[0], v1[1], v1[2], v1[3]};
        if (cg == 0) {
            float h[8], h2[8]; unpack8(*(const u32x4*)(hf + off), h); unpack8(*(const u32x4*)(hb + off), h2);
#pragma unroll
            for (int j = 0; j < 8; ++j) { const float x = v[j]; v[j] = (h[j] + h2[j]) * x * fsigmoid(1.5957691216057308f * (x + 0.044715f * x * x * x)); }
            *(u32x4*)(bra + off) = pack8(v);
        } else {
            float o[8], o2[8]; unpack8(*(const u32x4*)(of + off), o); unpack8(*(const u32x4*)(ob + off), o2);
            const float rs = rstdo[(size_t)row * 8 + (c >> 7)];
            const f32x4 g0 = *(const f32x4*)(hgg + c), g1 = *(const f32x4*)(hgg + c + 4);
            const float gv[8] = {g0[0], g0[1], g0[2], g0[3], g1[0], g1[1], g1[2], g1[3]};
#pragma unroll
            for (int j = 0; j < 8; ++j) v[j] = (o[j] + o2[j]) * rs * gv[j] * (v[j] * fsigmoid(v[j]));
            *(u32x4*)(brb + off) = pack8(v);
        }
    }
};
struct FP5b { bf16* sga; bf16* sgb;
    __device__ __forceinline__ void operator()(int row, int col, f32x4 v0, f32x4 v1) const {
        const int cg = col >> 10, c = col & 1023;
        float v[8] = {v0[0], v0[1], v0[2], v0[3], v1[0], v1[1], v1[2], v1[3]};
#pragma unroll
        for (int j = 0; j < 8; ++j) v[j] = fsigmoid(v[j]);
        *(u32x4*)((cg == 0 ? sga : sgb) + (size_t)row * DM + c) = pack8(v);
    }
};
struct FP3b1 { const bf16* sg; bf16* t1;
    __device__ __forceinline__ void operator()(int row, int col, f32x4 v0, f32x4 v1) const {
        float v[8] = {v0[0], v0[1], v0[2], v0[3], v1[0], v1[1], v1[2], v1[3]}; float s[8]; unpack8(*(const u32x4*)(sg + (size_t)row * DM + col), s);
#pragma unroll
        for (int j = 0; j < 8; ++j) v[j] *= s[j];
        *(u32x4*)(t1 + (size_t)row * DM + col) = pack8(v);
    }
};
struct FP3b2 { const bf16* sg; bf16* t1;
    __device__ __forceinline__ void operator()(int row, int col, f32x4 v0, f32x4 v1) const {
        float v[8] = {v0[0], v0[1], v0[2], v0[3], v1[0], v1[1], v1[2], v1[3]}; float s[8], t[8];
        unpack8(*(const u32x4*)(sg + (size_t)row * DM + col), s); unpack8(*(const u32x4*)(t1 + (size_t)row * DM + col), t);
#pragma unroll
        for (int j = 0; j < 8; ++j) v[j] = t[j] + v[j] * s[j];
        *(u32x4*)(t1 + (size_t)row * DM + col) = pack8(v);
    }
};
struct FP3c { const float* xp; const float* xs; float* x1;
    __device__ __forceinline__ void operator()(int row, int col, f32x4 v0, f32x4 v1) const {
        const float* xr = (row < NPROMPT_ROWS ? xp + (size_t)row * DM : xs + (size_t)(row - NPROMPT_ROWS) * DM) + col;
        float* o = x1 + (size_t)row * DM + col;
        *(f32x4*)o = *(const f32x4*)xr + v0; *(f32x4*)(o + 4) = *(const f32x4*)(xr + 4) + v1;
    }
};
struct FP4 { bf16* hlo; bf16* hhi;
    __device__ __forceinline__ void operator()(int row, int col, f32x4 v0, f32x4 v1) const {
        float v[8] = {v0[0], v0[1], v0[2], v0[3], v1[0], v1[1], v1[2], v1[3]};
#pragma unroll
        for (int j = 0; j < 8; ++j) { const float r = fmaxf(v[j], 0.f); v[j] = r * r; }
        bf16* o = row < HSPLIT_PM * 256 ? hlo + (size_t)row * DFF : hhi + (size_t)(row - HSPLIT_PM * 256) * DFF;
        *(u32x4*)(o + col) = pack8(v);
    }
};
struct FP5 { float* x1;
    __device__ __forceinline__ void operator()(int row, int col, f32x4 v0, f32x4 v1) const {
        float* o = x1 + (size_t)row * DM + col;
        *(f32x4*)o = *(const f32x4*)o + v0; *(f32x4*)(o + 4) = *(const f32x4*)(o + 4) + v1;
    }
};

#define XB_TMO      128
#define XB_XCNT(j)  (256  + 64 * (j))
#define XB_XSUB(j)  (1280 + 64 * (j))
#define XB_XGEN(j)  (2304 + 64 * (j))
#define XB_TOP      3328
#define XB_TOPGEN   3392
#define XCD_BAR_WORDS 3456
#define XB_SPIN_CAP (1u << 22)

__device__ __forceinline__ unsigned xb_ld(unsigned* p)              { return __hip_atomic_load(p, __ATOMIC_RELAXED, __HIP_MEMORY_SCOPE_AGENT); }
__device__ __forceinline__ unsigned xb_add(unsigned* p, unsigned v) { return __hip_atomic_fetch_add(p, v, __ATOMIC_RELAXED, __HIP_MEMORY_SCOPE_AGENT); }
__device__ __forceinline__ unsigned xb_xcc_id() { return (unsigned)__builtin_amdgcn_s_getreg((3 << 11) | 20) & 0xFu; }
#define XB_SPIN(cond, bar) do { unsigned _sp = 0; while (cond) { __builtin_amdgcn_s_sleep(1); \
    if ((++_sp & 255u) == 0u) { if (xb_ld(&(bar)[XB_TMO])) break; if (_sp > XB_SPIN_CAP) { atomicAdd(&(bar)[XB_TMO], 1u); break; } } } } while (0)

struct XcdBarrier {
    unsigned* bar; unsigned x;
    volatile LAS unsigned* st;
};

__device__ __forceinline__ XcdBarrier xcd_barrier_post(unsigned* bar, volatile LAS unsigned* st) {
    XcdBarrier b; b.bar = bar; b.x = xb_xcc_id(); b.st = st;
    if (threadIdx.x == 0) (void)xb_add(&bar[XB_XCNT(b.x)], 1u);
    return b;
}
__device__ __forceinline__ void xcd_barrier_complete(unsigned* bar, unsigned x, unsigned& nloc, unsigned& nx) {
    const unsigned G = gridDim.x * gridDim.y * gridDim.z;
    unsigned sum, cnt, mine, sp = 0u;
    for (;;) {
        sum = 0u; cnt = 0u; mine = 0u;
#pragma unroll
        for (unsigned j = 0; j < 16; ++j) { const unsigned c = xb_ld(&bar[XB_XCNT(j)]); sum += c; cnt += (c > 0u) ? 1u : 0u; mine = (j == x) ? c : mine; }
        if (sum == G) break;
        __builtin_amdgcn_s_sleep(1);
        if ((++sp & 255u) == 0u) { if (xb_ld(&bar[XB_TMO])) break; if (sp > XB_SPIN_CAP) { atomicAdd(&bar[XB_TMO], 1u); break; } }
    }
    nloc = mine > 0u ? mine : 1u; nx = cnt > 0u ? cnt : 1u;
}

__device__ __forceinline__ void xcd_barrier(const XcdBarrier& b) {
    asm volatile("s_waitcnt vmcnt(0)" ::: "memory");
    __syncthreads();
    if (threadIdx.x == 0) {
        unsigned* bar = b.bar;
        __builtin_amdgcn_s_waitcnt(0);
        unsigned nloc = b.st[0], nx = b.st[1];
        if (nloc == 0u) { xcd_barrier_complete(bar, b.x, nloc, nx); b.st[0] = nloc; b.st[1] = nx; }
        const unsigned old = xb_add(&bar[XB_XSUB(b.x)], 1u);
        const unsigned gen = old / nloc;
        if (old + 1u == (gen + 1u) * nloc) {
            __builtin_amdgcn_fence(__ATOMIC_RELEASE, "agent");
            asm volatile("s_waitcnt vmcnt(0)" ::: "memory");
            const unsigned og = xb_add(&bar[XB_TOP], 1u);
            const unsigned tg = og / nx;
            if (og + 1u == (tg + 1u) * nx) xb_add(&bar[XB_TOPGEN], 1u);
            else XB_SPIN(xb_ld(&bar[XB_TOPGEN]) == tg, bar);
            __builtin_amdgcn_fence(__ATOMIC_ACQUIRE, "agent");
            xb_add(&bar[XB_XGEN(b.x)], 1u);
            asm volatile("s_waitcnt vmcnt(0)" ::: "memory");
        } else {
            XB_SPIN(xb_ld(&bar[XB_XGEN(b.x)]) == gen, bar);
            __builtin_amdgcn_fence(__ATOMIC_ACQUIRE, "agent");
            asm volatile("s_waitcnt vmcnt(0)" ::: "memory");
        }
    }
    __syncthreads();
}

typedef short bf16x8s __attribute__((ext_vector_type(8)));
typedef short s16x4v __attribute__((ext_vector_type(4)));
__device__ __forceinline__ bf16x8s mk8(u32x4 w) { return __builtin_bit_cast(bf16x8s, w); }
__device__ __forceinline__ bf16x8s mk8(u32x2 lo, u32x2 hi) { u32x4 w; w.x = lo.x; w.y = lo.y; w.z = hi.x; w.w = hi.y; return __builtin_bit_cast(bf16x8s, w); }
__device__ __forceinline__ bf16x8s pack8f(f32x4 a, f32x4 b) { u32x4 w; w.x = pg8::cvt_pk_bf16(a[0], a[1]); w.y = pg8::cvt_pk_bf16(a[2], a[3]); w.z = pg8::cvt_pk_bf16(b[0], b[1]); w.w = pg8::cvt_pk_bf16(b[2], b[3]); return __builtin_bit_cast(bf16x8s, w); }
__device__ __forceinline__ u32x2 pack4f(f32x4 a) { u32x2 w; w.x = pg8::cvt_pk_bf16(a[0], a[1]); w.y = pg8::cvt_pk_bf16(a[2], a[3]); return w; }
__device__ __forceinline__ bf16 bf1(float x) { return (bf16)(pg8::cvt_pk_bf16(x, x) & 0xffffu); }
__device__ __forceinline__ u32x2 trrd(const LAS unsigned char* p) { return __builtin_bit_cast(u32x2, __builtin_amdgcn_ds_read_tr16_b64_v4i16((LAS s16x4v*)p)); }
#define WG_BARRIER() do { asm volatile("s_waitcnt lgkmcnt(0)" ::: "memory"); __builtin_amdgcn_s_barrier(); asm volatile("" ::: "memory"); } while (0)
#define MFMA16(a, b, c) __builtin_amdgcn_mfma_f32_16x16x32_bf16((a), (b), (c), 0, 0, 0)
__device__ __forceinline__ f32x4 unpk4(u32x2 w) { f32x4 o; o[0] = __uint_as_float(w.x << 16); o[1] = __uint_as_float(w.x & 0xffff0000u); o[2] = __uint_as_float(w.y << 16); o[3] = __uint_as_float(w.y & 0xffff0000u); return o; }

constexpr int HG_PITCH = 272;
constexpr int HG_RAW = 0, HG_RAWSZ = 26112;
constexpr int HG_QD = 52224, HG_KD = 60928, HG_GV = 69632, HG_PT = 70144, HG_OST = 71680;
__device__ __forceinline__ long hg_row(int dir, int s, int u) { return dir == 0 ? (u < 16 ? -1L : (u < 32 ? (long)(MREAL + u - 16) : (long)s * SEQ + (u - 32))) : (long)s * SEQ + (SEQ - 1 - u); }

#define HG_BODY(c, PQ_, PG_, PV_, NQ_, NG_, NV_) \
        const LAS unsigned char* RB = L + HG_RAW + (c & 1) * HG_RAWSZ; \
        { const int c2 = c + 2 < nchunk ? c + 2 : nchunk - 1; const long r = hg_row(dir, s, 32 * c2 + srow); \
            NQ_ = *(const u32x4*)(Q + r * DM + 8 * scc); NG_ = *(const u32x4*)(G + r * DM + 8 * scc); NV_ = *(const u32x4*)(V + r * DM + 8 * scc); } \
 \
        { const LAS unsigned char* gp = RB + 8704 + (8 * h + tq) * HG_PITCH + (16 * w + 4 * tp) * 2; \
          const bf16x8s Ag = mk8(trrd(gp), trrd(gp + 4 * HG_PITCH)); \
          const f32x4 z = {0.f, 0.f, 0.f, 0.f}; \
          const f32x4 b0 = MFMA16(Ag, Lt0, z), b1 = MFMA16(Ag, Lt1, z); \
          f32x4 bmid, blast; \
_Pragma("unroll") \
          for (int r = 0; r < 4; ++r) { bmid[r] = __shfl(b0[r], (lane & 48) | 15); blast[r] = __shfl(b1[r], (lane & 48) | 15); } \
          const LAS unsigned char* qp = RB + i * HG_PITCH + (16 * w + 4 * h) * 2; \
          const f32x4 q0 = unpk4(*(const LAS u32x2*)qp), q1 = unpk4(*(const LAS u32x2*)(qp + 16 * HG_PITCH)); \
          const f32x4 g0 = unpk4(*(const LAS u32x2*)(qp + 8704)), g1 = unpk4(*(const LAS u32x2*)(qp + 8704 + 16 * HG_PITCH)); \
          f32x4 qd0, qd1, kd0, kd1; \
_Pragma("unroll") \
          for (int r = 0; r < 4; ++r) { \
              qd0[r] = q0[r] * __expf(b0[r] - bmid[r]); kd0[r] = (1.f - __expf(g0[r])) * __expf(bmid[r] - b0[r]); \
              qd1[r] = q1[r] * __expf(b1[r] - bmid[r]); kd1[r] = (1.f - __expf(g1[r])) * __expf(bmid[r] - b1[r]); } \
          LAS unsigned char* dq = L + HG_QD + i * HG_PITCH + (16 * w + 4 * h) * 2; \
          *(LAS u32x2*)dq = pack4f(qd0); *(LAS u32x2*)(dq + 16 * HG_PITCH) = pack4f(qd1); *(LAS u32x2*)(dq + 8704) = pack4f(kd0); *(LAS u32x2*)(dq + 8704 + 16 * HG_PITCH) = pack4f(kd1); \
          f32x4 gs; \
_Pragma("unroll") \
          for (int r = 0; r < 4; ++r) { gs[r] = Eprev[r] * __expf(bmid[r]); Eprev[r] = __expf(blast[r] - bmid[r]); } \
          if (i == 0) *(LAS f32x4*)(L + HG_GV + (16 * w + 4 * h) * 4) = gs; } \
        WG_BARRIER(); \
 \
        if (c + 1 < nchunk) { LAS unsigned char* rb = L + HG_RAW + ((c + 1) & 1) * HG_RAWSZ + srow * HG_PITCH + 16 * scc; *(LAS u32x4*)rb = PQ_; *(LAS u32x4*)(rb + 8704) = PG_; *(LAS u32x4*)(rb + 17408) = PV_; } \
 \
        bf16x8s Bs[4]; \
_Pragma("unroll") \
        for (int kt = 0; kt < 8; ++kt) S[kt] = S[kt] * *(const LAS f32x4*)(L + HG_GV + (16 * kt + 4 * h) * 4); \
_Pragma("unroll") \
        for (int ks = 0; ks < 4; ++ks) Bs[ks] = pack8f(S[2 * ks], S[2 * ks + 1]); \
        f32x4 acc0 = {0.f, 0.f, 0.f, 0.f}, acc1 = {0.f, 0.f, 0.f, 0.f}; \
_Pragma("unroll") \
        for (int ks = 0; ks < 4; ++ks) { \
            const LAS unsigned char* q0 = L + HG_QD + i * HG_PITCH + (32 * ks + 4 * h) * 2; const LAS unsigned char* q1 = q0 + 16 * HG_PITCH; \
            acc0 = MFMA16(Bs[ks], mk8(*(const LAS u32x2*)q0, *(const LAS u32x2*)(q0 + 32)), acc0); \
            acc1 = MFMA16(Bs[ks], mk8(*(const LAS u32x2*)q1, *(const LAS u32x2*)(q1 + 32)), acc1); \
        } \
        if (w < 3) { \
            const int mt = w == 0 ? 0 : 1, nt = w == 2 ? 1 : 0; f32x4 pt = {0.f, 0.f, 0.f, 0.f}; \
_Pragma("unroll") \
            for (int ks = 0; ks < 4; ++ks) pt = MFMA16(mk8(*(const LAS u32x4*)(L + HG_KD + (16 * nt + i) * HG_PITCH + (32 * ks + 8 * h) * 2)), mk8(*(const LAS u32x4*)(L + HG_QD + (16 * mt + i) * HG_PITCH + (32 * ks + 8 * h) * 2)), pt); \
            if (mt == nt) { \
_Pragma("unroll") \
                for (int r = 0; r < 4; ++r) if (4 * h + r > i) pt[r] = 0.f; } \
            *(LAS u32x2*)(L + HG_PT + w * 512 + lane * 8) = pack4f(pt); \
        } \
        WG_BARRIER(); \
        { const u32x2 p00 = *(const LAS u32x2*)(L + HG_PT + lane * 8), p10 = *(const LAS u32x2*)(L + HG_PT + 512 + lane * 8), p11 = *(const LAS u32x2*)(L + HG_PT + 1024 + lane * 8), z2 = {0u, 0u}; \
          const LAS unsigned char* vp = RB + 17408 + (4 * h + tq) * HG_PITCH + (16 * w + 4 * tp) * 2; \
          const bf16x8s Av = mk8(trrd(vp), trrd(vp + 16 * HG_PITCH)); \
          acc0 = MFMA16(Av, mk8(p00, z2), acc0); acc1 = MFMA16(Av, mk8(p10, p11), acc1); } \
 \
        { const LAS unsigned char* vp2 = RB + 17408 + (8 * h + tq) * HG_PITCH + (16 * w + 4 * tp) * 2; \
          const bf16x8s Bv2 = mk8(trrd(vp2), trrd(vp2 + 4 * HG_PITCH)); \
          const LAS unsigned char* kp = L + HG_KD + (8 * h + tq) * HG_PITCH + (4 * tp) * 2; \
_Pragma("unroll") \
          for (int kt = 0; kt < 8; ++kt) S[kt] = MFMA16(mk8(trrd(kp + 32 * kt), trrd(kp + 32 * kt + 4 * HG_PITCH)), Bv2, S[kt]); } \
 \
        { LAS unsigned char* op = L + HG_OST + i * HG_PITCH + (16 * w + 4 * h) * 2; *(LAS u32x2*)op = pack4f(acc0); *(LAS u32x2*)(op + 16 * HG_PITCH) = pack4f(acc1); } \
        WG_BARRIER(); \
        if (dir == 1 || c > 0) { const long r = hg_row(dir, s, 32 * c + srow); *(u32x4*)(G + r * DM + 8 * scc) = *(const LAS u32x4*)(L + HG_OST + srow * HG_PITCH + 16 * scc); }
__device__ __forceinline__ void phase_hgrn(const Args& a, LAS unsigned char* L, int item, int tid) {
    const int dir = item / 48, s = (item % 48) / 8, hd = item % 8;
    const int lane = tid & 63, w = __builtin_amdgcn_readfirstlane(tid >> 6), i = lane & 15, h = lane >> 4, tq = i >> 2, tp = i & 3;
    unsigned char* ws = a.ws;
    const bf16* Q = (const bf16*)(ws + WS_Q) + hd * 128; const bf16* V = (const bf16*)(ws + WS_V) + hd * 128;
    bf16* G = (bf16*)(ws + (dir == 0 ? WS_GF : WS_GB)) + hd * 128;
    const int nchunk = dir == 0 ? 257 : 256;
    const int srow = tid >> 4, scc = tid & 15;
    u32x4 rq, rg, rv;
    { const long r = hg_row(dir, s, srow); const u32x4 z = {0u, 0u, 0u, 0u};
      rq = r < 0 ? z : *(const u32x4*)(Q + r * DM + 8 * scc); rg = r < 0 ? z : *(const u32x4*)(G + r * DM + 8 * scc); rv = r < 0 ? z : *(const u32x4*)(V + r * DM + 8 * scc); }
    { LAS unsigned char* rb = L + HG_RAW + srow * HG_PITCH + 16 * scc; *(LAS u32x4*)rb = rq; *(LAS u32x4*)(rb + 8704) = rg; *(LAS u32x4*)(rb + 17408) = rv; }
    { const long r = hg_row(dir, s, 32 + srow); rq = *(const u32x4*)(Q + r * DM + 8 * scc); rg = *(const u32x4*)(G + r * DM + 8 * scc); rv = *(const u32x4*)(V + r * DM + 8 * scc); }
    u32x4 nq = rq, ng = rg, nv = rv;
    bf16x8s Lt0, Lt1;
#pragma unroll
    for (int j = 0; j < 8; ++j) { Lt0[j] = (8 * h + j <= i) ? (short)0x3f80 : (short)0; Lt1[j] = (8 * h + j <= 16 + i) ? (short)0x3f80 : (short)0; }
    f32x4 S[8];
#pragma unroll
    for (int kt = 0; kt < 8; ++kt) S[kt] = (f32x4){0.f, 0.f, 0.f, 0.f};
    f32x4 Eprev = {1.f, 1.f, 1.f, 1.f};
    WG_BARRIER();
    for (int c0 = 0; c0 < nchunk; c0 += 2) {
        { const int c = c0; HG_BODY(c, rq, rg, rv, nq, ng, nv) }
        if (c0 + 1 < nchunk) { const int c = c0 + 1; HG_BODY(c, nq, ng, nv, rq, rg, rv) }
    }
}

constexpr int RG_PITCH = 272;
constexpr int RG_RAW = 0, RG_XC = 36 * 272, RG_HST = RG_XC + 8704;
__device__ __forceinline__ long rg_row(int s, int p) { return (p < 0 || p >= LTOT) ? -1L : (p < NMETA ? (long)(MREAL + p) : (long)s * SEQ + (p - NMETA)); }

#define RG_STEP(D) { const float A1 = __builtin_bit_cast(float, __builtin_amdgcn_update_dpp(0x3f800000, __builtin_bit_cast(int, A), 0x110 + (D), 0xf, 0xf, false)); \
                     const float B1 = __builtin_bit_cast(float, __builtin_amdgcn_update_dpp(0, __builtin_bit_cast(int, B), 0x110 + (D), 0xf, 0xf, false)); B = A * B1 + B; A = A * A1; }
#define RG_BODY(c, P0_, P1_, PM0_, PM1_, N0_, N1_, NM0_, NM1_) \
        const int P0 = dir == 0 ? 32 * c - 16 : 8176 - 32 * c; \
        { const int c2 = c + 2 < ntile ? c + 2 : ntile - 1; RG_LOAD(dir == 0 ? 32 * c2 - 16 : 8176 - 32 * c2, N0_, N1_, NM0_, NM1_) } \
 \
        { const int off = dir == 0 ? srow : 31 - srow; float xc[8]; \
_Pragma("unroll") \
          for (int e = 0; e < 8; ++e) xc[e] = cbv[e]; \
_Pragma("unroll") \
          for (int m = 0; m < 4; ++m) { float x[8]; unpack8(*(const LAS u32x4*)(L + RG_RAW + (off + m) * RG_PITCH + 16 * scc), x); \
_Pragma("unroll") \
              for (int e = 0; e < 8; ++e) xc[e] += cw[m][e] * x[e]; } \
          *(LAS u32x4*)(L + RG_XC + srow * RG_PITCH + 16 * scc) = pack8(xc); } \
        WG_BARRIER(); \
        RG_STAGE(P0_, P1_, PM0_, PM1_) \
        f32x4 aa0 = {0.f, 0.f, 0.f, 0.f}, aa1 = aa0, ax0 = aa0, ax1 = aa0; \
_Pragma("unroll") \
        for (int ks = 0; ks < 4; ++ks) { const bf16x8s X0 = mk8(*(const LAS u32x4*)(L + RG_XC + i * RG_PITCH + (32 * ks + 8 * h) * 2)), X1 = mk8(*(const LAS u32x4*)(L + RG_XC + (16 + i) * RG_PITCH + (32 * ks + 8 * h) * 2)); \
            aa0 = MFMA16(Ba[ks], X0, aa0); aa1 = MFMA16(Ba[ks], X1, aa1); ax0 = MFMA16(Bx[ks], X0, ax0); ax1 = MFMA16(Bx[ks], X1, ax1); } \
 \
_Pragma("unroll") \
        for (int mt = 0; mt < 2; ++mt) { \
            const f32x4 pa = mt == 0 ? aa0 : aa1, px = mt == 0 ? ax0 : ax1; const int tau = 16 * mt + i; const int p = dir == 0 ? P0 + tau : P0 + 31 - tau; \
            const f32x4 xc4 = unpk4(*(const LAS u32x2*)(L + RG_XC + tau * RG_PITCH + (16 * w + 4 * h) * 2)); f32x4 o4; \
_Pragma("unroll") \
            for (int r = 0; r < 4; ++r) { \
                const float rgt = __builtin_amdgcn_rcpf(1.f + __builtin_amdgcn_exp2f(pa[r] + ba[r])), igt = __builtin_amdgcn_rcpf(1.f + __builtin_amdgcn_exp2f(px[r] + bx[r])); \
                const float aval = __builtin_amdgcn_exp2f(cl[r] * rgt); const float mult = __builtin_amdgcn_sqrtf(fmaxf(1.f - aval * aval, 0.f)); \
                float A = aval, B = p < 0 ? 0.f : mult * igt * xc4[r]; \
                RG_STEP(1) RG_STEP(2) RG_STEP(4) RG_STEP(8) \
                const float st = A * hc[r] + B; o4[r] = st; hc[r] = __shfl(st, (lane & 48) | 15); } \
            *(LAS u32x2*)(L + RG_HST + tau * RG_PITCH + (16 * w + 4 * h) * 2) = pack4f(o4); \
        } \
        WG_BARRIER(); \
        { const int p = dir == 0 ? P0 + srow : P0 + 31 - srow; \
          if (p >= NMETA) *(u32x4*)(HO + ((long)s * SEQ + (p - NMETA)) * DM + 8 * scc) = *(const LAS u32x4*)(L + RG_HST + srow * RG_PITCH + 16 * scc); }
__device__ __forceinline__ void phase_rglru(const Args& a, LAS unsigned char* L, int item, int tid) {
    const int dir = item / 48, s = (item % 48) / 8, hb = item % 8;
    const int lane = tid & 63, w = __builtin_amdgcn_readfirstlane(tid >> 6), i = lane & 15, h = lane >> 4;
    unsigned char* ws = a.ws;
    const bf16* XA = (const bf16*)(ws + WS_XA) + hb * 128; bf16* HO = (bf16*)((unsigned char*)a.out + (dir == 0 ? 0 : OUT_OB)) + hb * 128;
    constexpr float LOG2E = 1.4426950408889634f;
    bf16x8s Ba[4], Bx[4];
    { const float* wa = a.in[8] + (size_t)(dir * 8 + hb) * 16384 + 16 * w + i; const float* wx = a.in[10] + (size_t)(dir * 8 + hb) * 16384 + 16 * w + i;
#pragma unroll
      for (int ks = 0; ks < 4; ++ks) { float t[8], x[8];
#pragma unroll
          for (int j = 0; j < 8; ++j) { t[j] = -LOG2E * wa[(size_t)(32 * ks + 8 * h + j) * 128]; x[j] = -LOG2E * wx[(size_t)(32 * ks + 8 * h + j) * 128]; }
          Ba[ks] = mk8(pack8(t)); Bx[ks] = mk8(pack8(x)); } }
    float ba[4], bx[4], cl[4], hc[4];
#pragma unroll
    for (int r = 0; r < 4; ++r) { const int C = hb * 128 + 16 * w + 4 * h + r; ba[r] = -LOG2E * a.in[9][dir * DM + C]; bx[r] = -LOG2E * a.in[11][dir * DM + C]; cl[r] = LOG2E * ((const float*)(ws + WS_SMALL))[2048 + dir * DM + C]; hc[r] = 0.f; }
    const int srow = tid >> 4, scc = tid & 15;
    float cw[4][8], cbv[8];
#pragma unroll
    for (int m = 0; m < 4; ++m) { const f32x4 x0 = *(const f32x4*)(a.in[6] + m * DM + hb * 128 + 8 * scc), x1 = *(const f32x4*)(a.in[6] + m * DM + hb * 128 + 8 * scc + 4);
#pragma unroll
        for (int e = 0; e < 4; ++e) { cw[m][e] = x0[e]; cw[m][4 + e] = x1[e]; } }
    { const f32x4 x0 = *(const f32x4*)(a.in[7] + hb * 128 + 8 * scc), x1 = *(const f32x4*)(a.in[7] + hb * 128 + 8 * scc + 4);
#pragma unroll
      for (int e = 0; e < 4; ++e) { cbv[e] = x0[e]; cbv[4 + e] = x1[e]; } }
    const int ntile = dir == 0 ? 257 : 256;
#define RG_LOAD(P, v0, v1, m0, m1) { const long ra_ = rg_row(s, (P) - 2 + srow), rb_ = rg_row(s, (P) - 2 + 32 + (srow & 3)); m0 = ra_ >= 0; m1 = rb_ >= 0; \
        v0 = *(const u32x4*)(XA + (ra_ < 0 ? 0L : ra_) * DM + 8 * scc); v1 = *(const u32x4*)(XA + (rb_ < 0 ? 0L : rb_) * DM + 8 * scc); }
#define RG_STAGE(v0, v1, m0, m1) { *(LAS u32x4*)(L + RG_RAW + srow * RG_PITCH + 16 * scc) = (m0) ? v0 : z4; if (tid < 64) *(LAS u32x4*)(L + RG_RAW + (32 + srow) * RG_PITCH + 16 * scc) = (m1) ? v1 : z4; }
    u32x4 r0v, r1v, n0v, n1v; bool rm0, rm1, nm0, nm1; const u32x4 z4 = {0u, 0u, 0u, 0u};
    RG_LOAD(dir == 0 ? -16 : 8176, r0v, r1v, rm0, rm1)
    RG_STAGE(r0v, r1v, rm0, rm1)
    RG_LOAD(dir == 0 ? 16 : 8144, r0v, r1v, rm0, rm1)
    n0v = r0v; n1v = r1v; nm0 = rm0; nm1 = rm1;
    WG_BARRIER();
    for (int c0 = 0; c0 < ntile; c0 += 2) {
        { const int c = c0; RG_BODY(c, r0v, r1v, rm0, rm1, n0v, n1v, nm0, nm1) }
        if (c0 + 1 < ntile) { const int c = c0 + 1; RG_BODY(c, n0v, n1v, nm0, nm1, r0v, r1v, rm0, rm1) }
    }
}

__device__ __forceinline__ void transpose_item(const float* W, int K, int N, bf16* WT, int k0, int n0, int dst_row0, float* scr, int lane) {
#pragma unroll 8
    for (int i = 0; i < 32; ++i) { const int kk = 2 * i + (lane >> 5); scr[kk * 33 + (lane & 31)] = W[(size_t)(k0 + kk) * N + n0 + (lane & 31)]; }
    asm volatile("s_waitcnt lgkmcnt(0)" ::: "memory");
    const int c = lane & 7;
#pragma unroll
    for (int j = 0; j < 4; ++j) { const int n = (lane >> 3) + 8 * j; const float* s = scr + (8 * c) * 33 + n;
        u32x4 o; o.x = pk2(s[0 * 33], s[1 * 33]); o.y = pk2(s[2 * 33], s[3 * 33]); o.z = pk2(s[4 * 33], s[5 * 33]); o.w = pk2(s[6 * 33], s[7 * 33]);
        *(u32x4*)(WT + (size_t)(dst_row0 + n) * K + k0 + 8 * c) = o; }
    asm volatile("s_waitcnt lgkmcnt(0)" ::: "memory");
}
__device__ __forceinline__ void norm_row_bf16(const float* xrow, const float* gain, bf16* orow, int lane) {
    const f32x4* xr = (const f32x4*)xrow + lane; f32x4 v[4]; float s = 0.f;
#pragma unroll
    for (int j = 0; j < 4; ++j) { v[j] = xr[64 * j]; s += (v[j].x * v[j].x + v[j].y * v[j].y) + (v[j].z * v[j].z + v[j].w * v[j].w); }
    const float rstd = rsqrtf(wave_sum(s) * (1.f / DM) + EPS);
    u32x2* o8 = (u32x2*)orow + lane;
#pragma unroll
    for (int j = 0; j < 4; ++j) { const f32x4 g = ((const f32x4*)gain)[lane + 64 * j]; u32x2 w; w.x = pk2(v[j].x * rstd * g.x, v[j].y * rstd * g.y); w.y = pk2(v[j].z * rstd * g.z, v[j].w * rstd * g.w); o8[64 * j] = w; }
}
__device__ __forceinline__ int win_dst_group(int g) { return g == 0 ? 0 : g == 1 ? 5 : g <= 5 ? g - 1 : g; }

__device__ __forceinline__ void phase_prep0(const Args& a, float* scr, int gw, int NGW, int gtid, int lane) {
    unsigned char* ws = a.ws;
    { float* sm = (float*)(ws + WS_SMALL);
      if (gtid < 2048) { const float l0 = a.in[3][gtid], l1 = a.in[3][2048 + gtid]; const float m = fmaxf(l0, l1); const float e0 = expf(l0 - m), e1 = expf(l1 - m); sm[gtid] = e0 / (e0 + e1); }
      else if (gtid < 4096) { const float lam = a.in[12][gtid - 2048]; sm[gtid] = -8.f * log1pf(expf(-lam)); } }
    constexpr int I_WIN = (DM / 64) * (NIN / 32), I_SQ = (DM / 64) * (DM / 32);
    for (int it = gw; it < I_WIN + 3 * I_SQ; it += NGW) {
        int r = it;
        if (r < I_WIN) { const int nblk = NIN / 32, kb = r / nblk, nb = r % nblk, n0 = nb * 32; transpose_item(a.in[5], DM, NIN, (bf16*)(ws + WS_WINT), kb * 64, n0, win_dst_group(n0 >> 10) * 1024 + (n0 & 1023), scr, lane); continue; }
        r -= I_WIN; const int which = r / I_SQ; r %= I_SQ; const int nblk = DM / 32, kb = r / nblk, nb = r % nblk;
        transpose_item(a.in[14 + which], DM, DM, (bf16*)(ws + (which == 0 ? WS_WAT : which == 1 ? WS_WBT : WS_WOT)), kb * 64, nb * 32, nb * 32, scr, lane);
    }
    bf16* A0 = (bf16*)a.out;
    for (int m = gw; m < MPAD; m += NGW) {
        if (m < MREAL) norm_row_bf16(xrow_ptr(a, m), a.in[4], A0 + (size_t)m * DM, lane);
        else if (m < MREAL + NMETA) norm_row_bf16(a.in[2] + (size_t)(m - MREAL) * DM, a.in[4], A0 + (size_t)m * DM, lane);
        else { u32x4* o = (u32x4*)(A0 + (size_t)m * DM); o[lane] = (u32x4){0u, 0u, 0u, 0u}; o[lane + 64] = (u32x4){0u, 0u, 0u, 0u}; }
    }
}
__device__ __forceinline__ void phase_prep2(const Args& a, int gw, int NGW, int lane) {
    unsigned char* ws = a.ws; bf16* A0 = (bf16*)(ws + WS_A0B); const bf16* of = (const bf16*)(ws + WS_OF); const bf16* ob = (const bf16*)(ws + WS_OB); float* rstdo = (float*)(ws + WS_RSTDO);
    for (int m = gw; m < MREAL; m += NGW) {
        norm_row_bf16(xrow_ptr(a, m), a.in[4], A0 + (size_t)m * DM, lane);
        const u32x4* op = (const u32x4*)(of + (size_t)m * DM) + 2 * lane; const u32x4* oq = (const u32x4*)(ob + (size_t)m * DM) + 2 * lane;
        float o[8], p[8], o2[8], p2[8]; unpack8(op[0], o); unpack8(op[1], p); unpack8(oq[0], o2); unpack8(oq[1], p2); float ss = 0.f;
#pragma unroll
        for (int j = 0; j < 8; ++j) { const float x = o[j] + o2[j], y = p[j] + p2[j]; ss += x * x + y * y; }
        ss += __shfl_xor(ss, 1); ss += __shfl_xor(ss, 2); ss += __shfl_xor(ss, 4);
        if ((lane & 7) == 0) rstdo[(size_t)m * 8 + (lane >> 3)] = rsqrtf(ss * (1.f / 128.f) + EPS);
    }
}
__device__ __forceinline__ void phase_prep3(const Args& a, float* scr, int gw, int NGW, int lane) {
    unsigned char* ws = a.ws;
    constexpr int I_1 = (DM / 64) * (DFF / 32), I_2 = (DFF / 64) * (DM / 32);
    for (int it = gw; it < I_1 + I_2; it += NGW) {
        if (it < I_1) { const int nblk = DFF / 32, kb = it / nblk, nb = it % nblk; transpose_item(a.in[18], DM, DFF, (bf16*)(ws + WS_W1T), kb * 64, nb * 32, nb * 32, scr, lane); }
        else { const int r = it - I_1, nblk = DM / 32, kb = r / nblk, nb = r % nblk; transpose_item(a.in[19], DFF, DM, (bf16*)(ws + WS_W2T), kb * 64, nb * 32, nb * 32, scr, lane); }
    }
}
__device__ __forceinline__ void phase_norm1(const Args& a, int gw, int NGW, int lane) {
    unsigned char* ws = a.ws;
    for (int m = gw; m < MREAL; m += NGW) norm_row_bf16((const float*)(ws + WS_X1) + (size_t)m * DM, a.in[17], (bf16*)(ws + WS_A1) + (size_t)m * DM, lane);
}
__device__ __forceinline__ void phase_final(const Args& a, int gw, int NGW, int lane) {
    unsigned char* ws = a.ws;
    for (int m = gw; m < MREAL; m += NGW) {
        const f32x4* xr = (const f32x4*)((const float*)(ws + WS_X1) + (size_t)m * DM) + lane; f32x4 v[4]; float s = 0.f;
#pragma unroll
        for (int j = 0; j < 4; ++j) { v[j] = xr[64 * j]; s += (v[j].x * v[j].x + v[j].y * v[j].y) + (v[j].z * v[j].z + v[j].w * v[j].w); }
        const float rstd = rsqrtf(wave_sum(s) * (1.f / DM) + EPS);
        f32x4* o = (f32x4*)(a.out + (size_t)m * DM) + lane;
#pragma unroll
        for (int j = 0; j < 4; ++j) { const f32x4 g = ((const f32x4*)a.in[20])[lane + 64 * j]; o[64 * j] = v[j] * rstd * g; }
    }
}

constexpr int LDS_RING = 131072, LDSCTL_OFF = LDS_RING, LDS_BYTES = 147456;
__global__ void __launch_bounds__(512, 2) mega(Args a) {
    extern __shared__ __attribute__((aligned(16))) unsigned char lds[];
    PG8_LAS unsigned char* L = (PG8_LAS unsigned char*)lds;
    const int tid = threadIdx.x, lane = tid & 63, wave = __builtin_amdgcn_readfirstlane(tid >> 6);
    const int G = gridDim.x, gw = blockIdx.x * 8 + wave, NGW = G * 8, gtid = blockIdx.x * 512 + tid;
    unsigned char* ws = a.ws; bf16* outb = (bf16*)a.out; bf16* outb2 = (bf16*)((unsigned char*)a.out + OUT_OB);
    for (int u = tid; u < (LDS_BYTES - LDSCTL_OFF) / 4; u += 512) ((LAS unsigned*)(L + LDSCTL_OFF))[u] = 0u;
    __syncthreads();
    XcdBarrier bar = xcd_barrier_post((unsigned*)(ws + WS_CTL) + CW_BAR + a.li * XCD_BAR_WORDS, (volatile LAS unsigned*)(L + LDSCTL_OFF + 64));
    const int lo = a.ph_lo, hi = a.ph_hi;
#define IN(k) (lo <= (k) && (k) < hi)
#define SEAM(k) do { if ((k) + 1 < hi) xcd_barrier(bar); } while (0)
    float* scr = (float*)(lds + wave * 8448);
    constexpr int NOSPLIT = 1 << 30;
    pg8::StaticOrder S;
    if (IN(0)) { phase_prep0(a, scr, gw, NGW, gtid, lane); SEAM(0); }
    if (IN(1)) {
        pg8::Gemm g{outb, (const bf16*)(ws + WS_WINT), MPAD, NIN1, DM, outb, NOSPLIT}; S.init(MPAD, NIN1, G, blockIdx.x);
        pg8::EpiRow8<FP1> E{{(bf16*)(ws + WS_XA), (const float*)(ws + WS_SMALL)}};
        pg8::gemm_phase<pg8::EpiRow8<FP1>, pg8::StaticOrder, true, true>(L, g, S, E); SEAM(1);
    }
    if (IN(2)) { if (blockIdx.x < 192) { if ((blockIdx.x & 1) == 0) phase_hgrn(a, L, blockIdx.x >> 1, tid); else phase_rglru(a, L, blockIdx.x >> 1, tid); } SEAM(2); }
#ifdef REPEAT_RG
    if (IN(2)) { if (blockIdx.x < 192 && (blockIdx.x & 1)) phase_rglru(a, L, blockIdx.x >> 1, tid); SEAM(2); }
#endif
    if (IN(4)) { phase_prep2(a, gw, NGW, lane); SEAM(4); }
    if (IN(5)) {
        pg8::Gemm g{(const bf16*)(ws + WS_A0B), (const bf16*)(ws + WS_WINT) + (size_t)NIN1 * DM, MREAL, 2048, DM, (const bf16*)(ws + WS_A0B), NOSPLIT}; S.init(MREAL, 2048, G, blockIdx.x);
        pg8::EpiRow8<FP5a> E{{outb, outb2, (const bf16*)(ws + WS_OF), (const bf16*)(ws + WS_OB), (const float*)(ws + WS_RSTDO), a.in[13], (bf16*)(ws + WS_BRA), (bf16*)(ws + WS_BRB)}};
        pg8::gemm_phase<pg8::EpiRow8<FP5a>, pg8::StaticOrder, true, true>(L, g, S, E); SEAM(5);
    }
    if (IN(6)) {
        pg8::Gemm g{(const bf16*)(ws + WS_A0B), (const bf16*)(ws + WS_WINT) + (size_t)(NIN1 + 2048) * DM, MREAL, 2048, DM, (const bf16*)(ws + WS_A0B), NOSPLIT}; S.init(MREAL, 2048, G, blockIdx.x);
        pg8::EpiRow8<FP5b> E{{outb, outb2}};
        pg8::gemm_phase<pg8::EpiRow8<FP5b>, pg8::StaticOrder, true, true>(L, g, S, E); SEAM(6);
    }
    if (IN(7)) {
        pg8::Gemm g{(const bf16*)(ws + WS_BRA), (const bf16*)(ws + WS_WAT), MREAL, DM, DM, (const bf16*)(ws + WS_BRA), NOSPLIT}; S.init(MREAL, DM, G, blockIdx.x);
        pg8::EpiRow8<FP3b1> E{{outb, (bf16*)(ws + WS_T1)}};
        pg8::gemm_phase<pg8::EpiRow8<FP3b1>, pg8::StaticOrder, true, true>(L, g, S, E);
        __syncthreads(); phase_prep3(a, scr, gw, NGW, lane); SEAM(7);
    }
    if (IN(8)) {
        pg8::Gemm g{(const bf16*)(ws + WS_BRB), (const bf16*)(ws + WS_WBT), MREAL, DM, DM, (const bf16*)(ws + WS_BRB), NOSPLIT}; S.init(MREAL, DM, G, blockIdx.x);
        pg8::EpiRow8<FP3b2> E{{outb2, (bf16*)(ws + WS_T1)}};
        pg8::gemm_phase<pg8::EpiRow8<FP3b2>, pg8::StaticOrder, true, true>(L, g, S, E); SEAM(8);
    }
    if (IN(9)) {
        pg8::Gemm g{(const bf16*)(ws + WS_T1), (const bf16*)(ws + WS_WOT), MREAL, DM, DM, (const bf16*)(ws + WS_T1), NOSPLIT}; S.init(MREAL, DM, G, blockIdx.x);
        pg8::EpiRow8<FP3c> E{{a.in[0], a.in[1], (float*)(ws + WS_X1)}};
        pg8::gemm_phase<pg8::EpiRow8<FP3c>, pg8::StaticOrder, true, true>(L, g, S, E); SEAM(9);
    }
    if (IN(10)) { phase_norm1(a, gw, NGW, lane); SEAM(10); }
    if (IN(11)) {
        pg8::Gemm g{(const bf16*)(ws + WS_A1), (const bf16*)(ws + WS_W1T), MREAL, DFF, DM, (const bf16*)(ws + WS_A1), NOSPLIT}; S.init(MREAL, DFF, G, blockIdx.x);
        pg8::EpiRow8<FP4> E{{outb, (bf16*)(ws + WS_HHI)}};
        pg8::gemm_phase<pg8::EpiRow8<FP4>, pg8::StaticOrder, true, true>(L, g, S, E); SEAM(11);
    }
    if (IN(12)) {
        pg8::Gemm g{outb, (const bf16*)(ws + WS_W2T), MREAL, DM, DFF, (const bf16*)(ws + WS_HHI), HSPLIT_PM}; S.init(MREAL, DM, G, blockIdx.x);
        pg8::EpiRow8<FP5> E{{(float*)(ws + WS_X1)}};
        pg8::gemm_phase<pg8::EpiRow8<FP5>, pg8::StaticOrder, true, true>(L, g, S, E); SEAM(12);
    }
    if (IN(13)) { phase_final(a, gw, NGW, lane); }
#undef IN
#undef SEAM
}

extern "C" void kernel_launch(void* const* d_in, const int* in_sizes, int n_in, void* d_out, int out_size, void* d_ws, size_t ws_size, hipStream_t stream) {
    static int grid = 0;
    if (grid == 0) {
        if (n_in != 21 || out_size != MREAL * DM || ws_size < WS_END) { fprintf(stderr, "kernel_launch: unexpected shapes (n_in %d, out %d, ws %zu)\n", n_in, out_size, ws_size); grid = -1; return; }
        int dev = 0, cus = 0, per_cu = 0;
        if (hipGetDevice(&dev) != hipSuccess || hipDeviceGetAttribute(&cus, hipDeviceAttributeMultiprocessorCount, dev) != hipSuccess) { grid = -1; return; }
        if (hipFuncSetAttribute((const void*)mega, hipFuncAttributeMaxDynamicSharedMemorySize, LDS_BYTES) != hipSuccess) { fprintf(stderr, "kernel_launch: hipFuncSetAttribute failed\n"); grid = -1; return; }
        if (hipOccupancyMaxActiveBlocksPerMultiprocessor(&per_cu, (const void*)mega, 512, LDS_BYTES) != hipSuccess || per_cu < 1) { fprintf(stderr, "kernel_launch: occupancy query says %d workgroups per CU\n", per_cu); (void)hipGetLastError(); grid = -1; return; }
        grid = cus;
    }
    if (grid < 0) return;
    (void)hipMemsetAsync((char*)d_ws + WS_CTL, 0, CTL_BYTES, stream);
    Args a{};
    for (int i = 0; i < 21; ++i) a.in[i] = (const float*)d_in[i];
    a.out = (float*)d_out; a.ws = (unsigned char*)d_ws;
    a.ph_lo = 0; a.ph_hi = 14; a.li = 0;
    hipLaunchKernelGGL(mega, dim3(grid), dim3(512), LDS_BYTES, stream, a);
}
```
